# Optimizing an MI355X kernel written in HIP

```python
import math
import jax, jax.numpy as jnp
from jax import lax
import numpy as np

D_MODEL = 1024
BATCH = 4
SEQ = 8192
DEPTH = 4

CHUNK = 64
N_MIXERS = 2
N_POOL = (DEPTH + 1) // 2
N_FOX = DEPTH // 2
POOL_WINDOWS = (2, 4, 8, 16)
N_POOL_GROUPS = len(POOL_WINDOWS)
POOL_GROUP = D_MODEL // N_POOL_GROUPS
HEAD_DIM = 64
N_HEADS = D_MODEL // HEAD_DIM
Q_BLOCK = 128
NEG_INF = -1e30
N_EXPERTS = 32
TOP_K = 4
D_EXPERT = D_MODEL
SWIGLU_LIMIT = 7.0
SWIGLU_ALPHA = 1.702
EXPERT_BLOCK = 128
EPS = 1e-6

kernel_name = 'hybrid_pool_fox_moe_adaln_encoder'


def rmsnorm(x, g):
    x32 = x.astype(jnp.float32)
    y = x32 * lax.rsqrt(jnp.mean(x32 * x32, axis=-1, keepdims=True) + EPS)
    return (y * g.astype(jnp.float32)).astype(x.dtype)


def modulate(h, shift, scale):
    return h * (1 + scale[:, None, :]) + shift[:, None, :]


def pool_mixer(h, w_grp, scale):
    B, S, D = h.shape
    h32 = h.astype(jnp.float32)
    cs = jnp.concatenate([jnp.zeros((B, 1, D), jnp.float32), jnp.cumsum(h32, axis=1)], axis=1)
    t = jnp.arange(S)
    parts = []
    for g, w in enumerate(POOL_WINDOWS):
        sl = slice(g * POOL_GROUP, (g + 1) * POOL_GROUP)
        lo = jnp.maximum(t + 1 - w, 0)
        win_sum = cs[:, 1:, sl] - cs[:, lo, sl]
        cnt = jnp.minimum(t + 1, w).astype(jnp.float32)
        parts.append(win_sum / cnt[None, :, None] - h32[..., sl])
    d = jnp.stack(parts, axis=2).astype(h.dtype)
    y = jnp.einsum('bsgc,gcd->bsgd', d, w_grp).reshape(B, S, D)
    return y * scale


def forgetting_attention(h, w_in, b_f, w_o):
    B, S, D = h.shape
    proj = h @ w_in
    q = proj[..., :D].reshape(B, S, N_HEADS, HEAD_DIM)
    k = proj[..., D:2 * D].reshape(B, S, N_HEADS, HEAD_DIM)
    v = proj[..., 2 * D:3 * D].reshape(B, S, N_HEADS, HEAD_DIM)
    logf = jax.nn.log_sigmoid((proj[..., 3 * D:] + b_f).astype(jnp.float32))
    Ft = jnp.cumsum(logf, axis=1).transpose(0, 2, 1)
    kpos = jnp.arange(S)
    sm_scale = HEAD_DIM ** -0.5

    def attend(qi):
        s0 = qi * Q_BLOCK
        qb = lax.dynamic_slice_in_dim(q, s0, Q_BLOCK, axis=1)
        Fq = lax.dynamic_slice_in_dim(Ft, s0, Q_BLOCK, axis=2)
        logits = jnp.einsum('bqhd,bkhd->bhqk', qb, k, preferred_element_type=jnp.float32) * sm_scale
        logits = logits + Fq[..., :, None] - Ft[:, :, None, :]
        qpos = s0 + jnp.arange(Q_BLOCK)
        mask = qpos[:, None] >= kpos[None, :]
        p = jax.nn.softmax(jnp.where(mask, logits, NEG_INF), axis=-1)
        return jnp.einsum('bhqk,bkhd->bqhd', p.astype(v.dtype), v)

    o = lax.map(attend, jnp.arange(S // Q_BLOCK))
    o = o.transpose(1, 0, 2, 3, 4).reshape(B, S, D)
    return o @ w_o


def moe_ffn(h, router_w, router_b, w_in, b_in, w_out, b_out):
    B, S, D = h.shape
    T = B * S
    TK = T * TOP_K
    ht = h.reshape(T, D)
    logits = (ht @ router_w + router_b).astype(jnp.float32)
    top_v, top_i = lax.top_k(logits, TOP_K)
    gates = jax.nn.softmax(top_v, axis=-1)
    e_flat = top_i.reshape(-1)
    tok_flat = jnp.repeat(jnp.arange(T, dtype=jnp.int32), TOP_K)
    g_flat = gates.reshape(-1)
    order = jnp.argsort(e_flat, stable=True)
    e_sorted = e_flat[order]
    counts = jnp.bincount(e_flat, length=N_EXPERTS)
    padded = ((counts + EXPERT_BLOCK - 1) // EXPERT_BLOCK) * EXPERT_BLOCK
    start = jnp.cumsum(counts) - counts
    pend = jnp.cumsum(padded)
    pstart = pend - padded
    dest = pstart[e_sorted] + jnp.arange(TK) - start[e_sorted]
    n_blocks = TK // EXPERT_BLOCK + N_EXPERTS
    P = n_blocks * EXPERT_BLOCK
    row_tok = jnp.zeros((P,), jnp.int32).at[dest].set(tok_flat[order])
    row_gate = jnp.zeros((P,), jnp.float32).at[dest].set(g_flat[order])
    block_e = jnp.minimum(jnp.searchsorted(pend, jnp.arange(n_blocks) * EXPERT_BLOCK, side='right'), N_EXPERTS - 1)
    xs = ht[row_tok].reshape(n_blocks, EXPERT_BLOCK, D)

    def expert_block(args):
        xb, e = args
        gu = xb @ w_in[e] + b_in[e]
        gate = jnp.minimum(gu[:, :D_EXPERT], SWIGLU_LIMIT)
        up = jnp.clip(gu[:, D_EXPERT:], -SWIGLU_LIMIT, SWIGLU_LIMIT)
        act = (up + 1) * (gate * jax.nn.sigmoid(SWIGLU_ALPHA * gate))
        return act @ w_out[e] + b_out[e]

    ys = lax.map(expert_block, (xs, block_e)).reshape(P, D)
    out = jnp.zeros((T, D), jnp.float32).at[row_tok].add(ys.astype(jnp.float32) * row_gate[:, None])
    return out.astype(h.dtype).reshape(B, S, D)


def setup_inputs(seed: int = 0) -> dict:
    key = jax.random.key(seed)
    ks = jax.random.split(key, 20)
    D, H, E, F = D_MODEL, N_HEADS, N_EXPERTS, D_EXPERT
    nrm = jax.random.normal
    return {
        'x': nrm(ks[0], (BATCH, SEQ, D), jnp.float32),
        'c': nrm(ks[1], (BATCH, D), jnp.float32),
        'norm_mix_g': 1.0 + 0.05 * nrm(ks[2], (DEPTH, D), jnp.float32),
        'norm_ffn_g': 1.0 + 0.05 * nrm(ks[3], (DEPTH, D), jnp.float32),
        'ada_w': 0.5 * D ** -0.5 * nrm(ks[4], (DEPTH, D, 6 * D), jnp.float32),
        'ada_b': 0.02 * nrm(ks[5], (DEPTH, 6 * D), jnp.float32),
        'pool_w': POOL_GROUP ** -0.5 * nrm(ks[6], (N_POOL, N_POOL_GROUPS, POOL_GROUP, POOL_GROUP), jnp.float32),
        'pool_scale': 1.0 + 0.1 * nrm(ks[7], (N_POOL, D), jnp.float32),
        'fox_w_in': D ** -0.5 * nrm(ks[8], (N_FOX, D, 3 * D + H), jnp.float32),
        'fox_b_f': 2.0 + 0.1 * nrm(ks[9], (N_FOX, H), jnp.float32),
        'fox_w_o': D ** -0.5 * nrm(ks[10], (N_FOX, D, D), jnp.float32),
        'router_w': D ** -0.5 * nrm(ks[11], (DEPTH, D, E), jnp.float32),
        'router_b': 0.01 * nrm(ks[12], (DEPTH, E), jnp.float32),
        'exp_w_in': D ** -0.5 * nrm(ks[13], (DEPTH, E, D, 2 * F), jnp.float32),
        'exp_b_in': 0.02 * nrm(ks[14], (DEPTH, E, 2 * F), jnp.float32),
        'exp_w_out': F ** -0.5 * nrm(ks[15], (DEPTH, E, F, D), jnp.float32),
        'exp_b_out': 0.02 * nrm(ks[16], (DEPTH, E, D), jnp.float32),
        'final_g': 1.0 + 0.05 * nrm(ks[17], (D,), jnp.float32),
    }


def reference(x, c, norm_mix_g, norm_ffn_g, ada_w, ada_b, pool_w, pool_scale, fox_w_in, fox_b_f, fox_w_o,
              router_w, router_b, exp_w_in, exp_b_in, exp_w_out, exp_b_out, final_g):
    cond = jax.nn.silu(c)
    for i in range(DEPTH):
        mod = cond @ ada_w[i] + ada_b[i]
        sh1, sc1, g1, sh2, sc2, g2 = jnp.split(mod, 6, axis=-1)
        h = modulate(rmsnorm(x, norm_mix_g[i]), sh1, sc1)
        j = i // N_MIXERS
        if i % N_MIXERS == 0:
            m = pool_mixer(h, pool_w[j], pool_scale[j])
        else:
            m = forgetting_attention(h, fox_w_in[j], fox_b_f[j], fox_w_o[j])
        x = x + g1[:, None, :] * m
        h = modulate(rmsnorm(x, norm_ffn_g[i]), sh2, sc2)
        x = x + g2[:, None, :] * moe_ffn(h, router_w[i], router_b[i], exp_w_in[i], exp_b_in[i], exp_w_out[i], exp_b_out[i])
    return rmsnorm(x, final_g)
```

```cpp
#include <hip/hip_runtime.h>
#include <hip/hip_bf16.h>
#include <cstdio>
#include <cstdint>
#include <cmath>

#ifndef MK_N_LAUNCHES
#define MK_N_LAUNCHES 1
#endif
#ifndef MK_NBRANCH
#define MK_NBRANCH 8
#endif

constexpr int D = 1024, BATCH = 4, SEQ = 8192, T = BATCH * SEQ, DEPTH = 4, NEXP = 32, TOPK = 4, NH = 16, HD = 64, FF = 1024;
constexpr int NQKV = 3 * D, FOX_LD = 3 * D + NH;
constexpr float EPS = 1e-6f;
constexpr int MAXMT = T * TOPK / 256 + NEXP;

#define GAS __attribute__((address_space(1)))
#define LAS __attribute__((address_space(3)))

namespace pg8 {
#define PG8_LAS __attribute__((address_space(3)))
typedef unsigned short bf16_t;
typedef short bf16x8 __attribute__((ext_vector_type(8)));
typedef float f32x4 __attribute__((ext_vector_type(4)));
typedef float f32x2 __attribute__((ext_vector_type(2)));
typedef unsigned u32x4 __attribute__((ext_vector_type(4)));
typedef unsigned u32x2 __attribute__((ext_vector_type(2)));
typedef int v4i __attribute__((ext_vector_type(4)));
typedef int v8i __attribute__((ext_vector_type(8)));
constexpr int BM = 256, BK = 64, HALF = 128, HTB = HALF * BK * 2, STAGE_BYTES = 8 * HTB, NXCD = 8, WGM = 4;
constexpr int IDX_BYTES = 9216;

__host__ __device__ __forceinline__ int lds_byte(int r, int c) { const int st = (r >> 4) * 2 + (c >> 5), rr = r & 15, cc = c & 31, ob = rr * 64 + cc * 2; return st * 1024 + (ob ^ (((ob >> 9) & 1) << 5)); }
__host__ __device__ __forceinline__ void stage_rc(int b, int& R, int& C) { const int st = b / 1024, sb = b % 1024, swz = sb ^ (((sb >> 9) & 1) << 5); R = (st >> 1) * 16 + swz / 64; C = (st & 1) * 32 + (swz % 64) / 2; }
__host__ __device__ __forceinline__ int perm32(int rho) { const int n = rho >> 4, i = rho & 15; return 8 * (i >> 2) + 4 * n + (i & 3); }

__device__ __forceinline__ f32x4 zero4() { float z0, z1, z2, z3; asm volatile("v_mov_b32 %0, 0\n\tv_mov_b32 %1, 0\n\tv_mov_b32 %2, 0\n\tv_mov_b32 %3, 0" : "=v"(z0), "=v"(z1), "=v"(z2), "=v"(z3)); return (f32x4){z0, z1, z2, z3}; }
struct Unit { int pm, pn, e, cnt, mloc; };

__device__ __forceinline__ unsigned cvt_pk_bf16(float lo, float hi) { unsigned r; asm volatile("v_cvt_pk_bf16_f32 %0, %1, %2" : "=v"(r) : "v"(lo), "v"(hi)); return r; }

__device__ __forceinline__ float clamp448(float x) { return __builtin_amdgcn_fmed3f(x, -448.0f, 448.0f); }
__device__ __forceinline__ unsigned pk4_fp8(float a, float b, float c, float d) { int w; asm volatile("v_mov_b32 %0, 0" : "=v"(w));
    w = __builtin_amdgcn_cvt_pk_fp8_f32(clamp448(a), clamp448(b), w, false); w = __builtin_amdgcn_cvt_pk_fp8_f32(clamp448(c), clamp448(d), w, true); return (unsigned)w; }
constexpr float FP8_SW = 64.0f, FP8_SA = 4.0f;

__device__ __forceinline__ bool tile_order(int i, int G, int c, int nM, int nN, int& pm, int& pn) {
    const int nwg = nM * nN; const long L = (long)i * G + c; if (L >= nwg) return false;
    int wgid = (int)L; { const int q = nwg / NXCD, r = nwg % NXCD, xcd = wgid % NXCD, off = wgid / NXCD; wgid = (xcd < r ? xcd * (q + 1) : r * (q + 1) + (xcd - r) * q) + off; }
    const int nig = WGM * nN, gid = wgid / nig, fm = gid * WGM, gsz = (nM - fm) < WGM ? (nM - fm) : WGM;
    pm = fm + ((wgid % nig) % gsz); pn = (wgid % nig) / gsz; return true;
}

template <bool RO = false> struct SchedDenseT {
    static constexpr bool IDX = false, GATHER_A = false, GATE = false, ROWOFF_A = RO;
    const char* A; const char* Bt; size_t tstepA, tstepB; int a_pn_bytes; int nM, nN, G, c;
    __device__ __forceinline__ bool next(int i, Unit& u) const { u.e = 0; u.cnt = 256; u.mloc = 0; return tile_order(i, G, c, nM, nN, u.pm, u.pn); }
    __device__ __forceinline__ void ptrs(const Unit& u, const char*& cA, const char*& cB) const { cA = A + (RO ? (size_t)0 : (size_t)u.pm * tstepA) + (size_t)u.pn * a_pn_bytes; cB = Bt + (size_t)u.pn * tstepB; }
    __device__ __forceinline__ void issue_idx(const Unit&, PG8_LAS unsigned char*, int, int, int) const {}
};
typedef SchedDenseT<false> SchedDense;
template <bool GA, bool GT>
struct SchedMoe {
    static constexpr bool IDX = true, GATHER_A = GA, GATE = GT, ROWOFF_A = !GA;
    const char* A; const char* Bt; size_t tstepA, e_stepB, tstepB;
    const int* slot_pair; const float* slot_gate; const float* bias;
    const PG8_LAS int* ul;
    __device__ __forceinline__ bool next(int i, Unit& u) const {
        const PG8_LAS int* p = ul + 5 * i; const int pm = __builtin_amdgcn_readfirstlane(p[0]); if (pm < 0) return false;
        u.pm = pm; u.pn = __builtin_amdgcn_readfirstlane(p[1]); u.e = __builtin_amdgcn_readfirstlane(p[2]); u.cnt = __builtin_amdgcn_readfirstlane(p[3]); u.mloc = __builtin_amdgcn_readfirstlane(p[4]); return true;
    }
    __device__ __forceinline__ void ptrs(const Unit& u, const char*& cA, const char*& cB) const {
        cA = A; cB = Bt + (size_t)u.e * e_stepB + (size_t)u.pn * tstepB; }
    __device__ __forceinline__ void issue_idx(const Unit& u, PG8_LAS unsigned char* ldsx, int buf, int wid, int lane) const {
        asm volatile("" : "+v"(lane));
        int pos = u.mloc * 256 + (wid & 3) * 64 + lane; pos = pos < u.cnt ? pos : u.cnt - 1;
        const size_t off = (size_t)u.e * T + pos;
        if (wid < 4) __builtin_amdgcn_global_load_lds((const unsigned*)(slot_pair + off), (PG8_LAS unsigned*)(ldsx + buf * 1024 + wid * 256), 4, 0, 0);
        else if (GT) __builtin_amdgcn_global_load_lds((const unsigned*)(slot_gate + off), (PG8_LAS unsigned*)(ldsx + 3072 + buf * 1024 + (wid - 4) * 256), 4, 0, 0);
        if (GA) { if (wid >= 4) { const int w4 = wid - 4; const float* bp = bias + (size_t)u.e * 2048 + (w4 >> 1) * 1024 + u.pn * 128 + (w4 & 1) * 64 + lane;
                    __builtin_amdgcn_global_load_lds((const unsigned*)bp, (PG8_LAS unsigned*)(ldsx + 6144 + buf * 1024 + w4 * 256), 4, 0, 0); } }
        else { if (wid < 4) { const float* bp = bias + (size_t)u.e * 1024 + u.pn * 256 + wid * 64 + lane;
                    __builtin_amdgcn_global_load_lds((const unsigned*)bp, (PG8_LAS unsigned*)(ldsx + 6144 + buf * 1024 + wid * 256), 4, 0, 0); } }
    }
};

template <int CTRL> __device__ __forceinline__ float dpp_maxf(float v) { return fmaxf(v, __builtin_bit_cast(float, __builtin_amdgcn_update_dpp(0, __builtin_bit_cast(int, v), CTRL, 0xF, 0xF, false))); }
struct EpiQKV {
    static constexpr bool WIDE_N = true;
    static constexpr int PERM = 1;
    bf16_t* O; size_t split_stride; float scale0, sall; unsigned* qn2; unsigned* kn2;
    __device__ __forceinline__ void operator()(const f32x4 (&acc)[2][2][4][2], const Unit& u, int wr, int wc, int fr, int fq, PG8_LAS unsigned char*, int) const {
        const int row0 = u.pm * BM + wr * 64 + fr; int colt = u.pn * BM; const int t = colt / 1024; bf16_t* base = O + (size_t)t * split_stride; colt -= t * 1024;
        const float sc = ((t == 0) ? scale0 : 1.f) * sall; const int col0 = colt + wc * 32 + 8 * fq;
        float mx[2] = {0.f, 0.f};
#pragma unroll
        for (int ai = 0; ai < 2; ++ai)
#pragma unroll
            for (int m = 0; m < 4; ++m) { bf16_t* rowp = base + (size_t)(row0 + ai * HALF + m * 16) * 1024 + col0;
#pragma unroll
                for (int bj = 0; bj < 2; ++bj) { const f32x4 v0 = acc[ai][bj][m][0] * sc, v1 = acc[ai][bj][m][1] * sc;
                    u32x4 w; w.x = cvt_pk_bf16(v0[0], v0[1]); w.y = cvt_pk_bf16(v0[2], v0[3]); w.z = cvt_pk_bf16(v1[0], v1[1]); w.w = cvt_pk_bf16(v1[2], v1[3]);
                    *(u32x4*)(rowp + bj * HALF) = w;
                    if (t < 2) { float ss = (v0[0] * v0[0] + v0[1] * v0[1]) + (v0[2] * v0[2] + v0[3] * v0[3]) + (v1[0] * v1[0] + v1[1] * v1[1]) + (v1[2] * v1[2] + v1[3] * v1[3]);
                        { const auto r = __builtin_amdgcn_permlane16_swap(__float_as_uint(ss), __float_as_uint(ss), false, false); ss = __uint_as_float(r[0]) + __uint_as_float(r[1]); }
                        { const auto r = __builtin_amdgcn_permlane32_swap(__float_as_uint(ss), __float_as_uint(ss), false, false); ss = __uint_as_float(r[0]) + __uint_as_float(r[1]); }
                        mx[bj] = fmaxf(mx[bj], ss); } } }
        if (t < 2) {
#pragma unroll
            for (int bj = 0; bj < 2; ++bj) { float m_ = mx[bj]; m_ = dpp_maxf<0xB1>(m_); m_ = dpp_maxf<0x4E>(m_); m_ = dpp_maxf<0x141>(m_); m_ = dpp_maxf<0x140>(m_);
                if (fr == 0 && fq == 0) { const int bh = (u.pm >> 5) * 16 + (colt >> 6) + bj * 2 + (wc >> 1), half = wc & 1;
                    if (t == 0) __hip_atomic_fetch_max(qn2 + ((size_t)bh * 32 + (u.pm & 31)) * 2 + half, __float_as_uint(m_), __ATOMIC_RELAXED, __HIP_MEMORY_SCOPE_AGENT);
                    else        __hip_atomic_fetch_max(kn2 + (size_t)bh * 2 + half, __float_as_uint(m_), __ATOMIC_RELAXED, __HIP_MEMORY_SCOPE_AGENT); } }
        }
    }
};
struct EpiResid {
    static constexpr bool WIDE_N = false;
    static constexpr int PERM = 1;
    const void* src; bool src_bf; bf16_t* dst; const float* cs; int cs_bstride; float s;
    __device__ __forceinline__ void operator()(const f32x4 (&acc)[2][2][4][2], const Unit& u, int wr, int wc, int fr, int fq, PG8_LAS unsigned char*, int) const {
        const int row0 = u.pm * BM + wr * 64 + fr, col0 = u.pn * BM + wc * 32 + 8 * fq; const int b = (u.pm * BM) / SEQ;
        f32x4 cv[2][2];
#pragma unroll
        for (int bj = 0; bj < 2; ++bj)
#pragma unroll
            for (int n = 0; n < 2; ++n) cv[bj][n] = *(const f32x4*)(cs + (size_t)b * cs_bstride + col0 + bj * HALF + 4 * n) * s;
        if (src_bf) {
            u32x4 wq[2][4];
#define ER_OFF(bt, mm) ((size_t)(row0 + ((bt) >> 1) * HALF + (2 * ((bt) & 1) + (mm)) * 16) * 1024 + col0)
#define ER_LD(bt, W) do { _Pragma("unroll") for (int mm = 0; mm < 2; ++mm) { _Pragma("unroll") for (int bj = 0; bj < 2; ++bj) W[mm * 2 + bj] = *(const u32x4*)((const bf16_t*)src + ER_OFF(bt, mm) + bj * HALF); } } while (0)
#define ER_ST(bt, W) do { _Pragma("unroll") for (int mm = 0; mm < 2; ++mm) { _Pragma("unroll") for (int bj = 0; bj < 2; ++bj) { const u32x4 w = W[mm * 2 + bj]; \
                const f32x4 x0 = (f32x4){__uint_as_float(w.x << 16), __uint_as_float(w.x & 0xffff0000u), __uint_as_float(w.y << 16), __uint_as_float(w.y & 0xffff0000u)}; \
                const f32x4 x1 = (f32x4){__uint_as_float(w.z << 16), __uint_as_float(w.z & 0xffff0000u), __uint_as_float(w.w << 16), __uint_as_float(w.w & 0xffff0000u)}; \
                const f32x4 y0 = x0 + cv[bj][0] * acc[(bt) >> 1][bj][2 * ((bt) & 1) + mm][0], y1 = x1 + cv[bj][1] * acc[(bt) >> 1][bj][2 * ((bt) & 1) + mm][1]; \
                u32x4 o; o.x = cvt_pk_bf16(y0[0], y0[1]); o.y = cvt_pk_bf16(y0[2], y0[3]); o.z = cvt_pk_bf16(y1[0], y1[1]); o.w = cvt_pk_bf16(y1[2], y1[3]); \
                *(u32x4*)(dst + ER_OFF(bt, mm) + bj * HALF) = o; } } } while (0)
            ER_LD(0, wq[0]); ER_LD(1, wq[1]); asm volatile("" ::: "memory");
            ER_ST(0, wq[0]); ER_LD(2, wq[0]); asm volatile("" ::: "memory");
            ER_ST(1, wq[1]); ER_LD(3, wq[1]); asm volatile("" ::: "memory");
            ER_ST(2, wq[0]); asm volatile("" ::: "memory");
            ER_ST(3, wq[1]);
#undef ER_OFF
#undef ER_LD
#undef ER_ST
            return;
        }
#pragma unroll
        for (int ai = 0; ai < 2; ++ai)
#pragma unroll
            for (int m = 0; m < 4; ++m) { const size_t off = (size_t)(row0 + ai * HALF + m * 16) * 1024 + col0;
#pragma unroll
                for (int bj = 0; bj < 2; ++bj) { f32x4 x0, x1;
                    if (src_bf) { const u32x4 w = *(const u32x4*)((const bf16_t*)src + off + bj * HALF);
                        x0 = (f32x4){__uint_as_float(w.x << 16), __uint_as_float(w.x & 0xffff0000u), __uint_as_float(w.y << 16), __uint_as_float(w.y & 0xffff0000u)};
                        x1 = (f32x4){__uint_as_float(w.z << 16), __uint_as_float(w.z & 0xffff0000u), __uint_as_float(w.w << 16), __uint_as_float(w.w & 0xffff0000u)}; }
                    else { x0 = *(const f32x4*)((const float*)src + off + bj * HALF); x1 = *(const f32x4*)((const float*)src + off + bj * HALF + 4); }
                    const f32x4 y0 = x0 + cv[bj][0] * acc[ai][bj][m][0], y1 = x1 + cv[bj][1] * acc[ai][bj][m][1];
                    u32x4 o; o.x = cvt_pk_bf16(y0[0], y0[1]); o.y = cvt_pk_bf16(y0[2], y0[3]); o.z = cvt_pk_bf16(y1[0], y1[1]); o.w = cvt_pk_bf16(y1[2], y1[3]);
                    *(u32x4*)(dst + off + bj * HALF) = o; }
                if (m & 1) asm volatile("" ::: "memory"); }
    }
};
constexpr float SWG_C = -1.702f * 1.4426950408889634f;
__device__ __forceinline__ f32x2 swiglu_pk(f32x2 tg, f32x2 uq) {
    tg.x = fmaxf(tg.x, 7.0f * SWG_C); tg.y = fmaxf(tg.y, 7.0f * SWG_C); uq.x = __builtin_amdgcn_fmed3f(uq.x, 32.0f / SWG_C, -24.0f / SWG_C); uq.y = __builtin_amdgcn_fmed3f(uq.y, 32.0f / SWG_C, -24.0f / SWG_C);
    f32x2 d; d.x = __builtin_amdgcn_exp2f(tg.x); d.y = __builtin_amdgcn_exp2f(tg.y); d = d + 1.0f;
    f32x2 r; r.x = __builtin_amdgcn_rcpf(d.x); r.y = __builtin_amdgcn_rcpf(d.y);
    return (tg * r) * uq;
}
__device__ __forceinline__ unsigned pk4_fp8_raw(f32x2 a, f32x2 b) { int w; asm volatile("v_mov_b32 %0, 0" : "=v"(w)); w = __builtin_amdgcn_cvt_pk_fp8_f32(a.x, a.y, w, false); w = __builtin_amdgcn_cvt_pk_fp8_f32(b.x, b.y, w, true); return (unsigned)w; }
struct EpiSwiglu {
    static constexpr bool WIDE_N = true;
    static constexpr int PERM = 1;
    unsigned char* act; float s;
    __device__ __forceinline__ void operator()(const f32x4 (&acc)[2][2][4][2], const Unit& u, int wr, int wc, int fr, int fq, PG8_LAS unsigned char* ldsx, int buf) const {
        const int row0 = u.pm * BM + wr * 64 + fr, colh = u.pn * HALF + wc * 32 + 8 * fq;
        const PG8_LAS float* bb = (const PG8_LAS float*)(ldsx + 6144 + buf * 1024) + wc * 32 + 8 * fq;
        const float sg = s * SWG_C, su = s * (FP8_SA / SWG_C);
        const f32x4 bg0 = *(const PG8_LAS f32x4*)(bb) * SWG_C, bg1 = *(const PG8_LAS f32x4*)(bb + 4) * SWG_C, bu0 = (*(const PG8_LAS f32x4*)(bb + 128) + 1.0f) * (FP8_SA / SWG_C), bu1 = (*(const PG8_LAS f32x4*)(bb + 132) + 1.0f) * (FP8_SA / SWG_C);
        static_assert(FP8_SA == 4.0f, "swiglu_pk folds the activation scale 4");
        const int fqe = fq & ~1, rsel = fq & 1;
#pragma unroll
        for (int ai = 0; ai < 2; ++ai)
#pragma unroll
            for (int mp = 0; mp < 2; ++mp) {
                u32x2 w[2];
#pragma unroll
                for (int mm = 0; mm < 2; ++mm) { const int m = 2 * mp + mm;
                    const f32x4 g0 = acc[ai][0][m][0] * sg + bg0, g1 = acc[ai][0][m][1] * sg + bg1, u0 = acc[ai][1][m][0] * su + bu0, u1 = acc[ai][1][m][1] * su + bu1;
                    w[mm].x = pk4_fp8_raw(swiglu_pk((f32x2){g0[0], g0[1]}, (f32x2){u0[0], u0[1]}), swiglu_pk((f32x2){g0[2], g0[3]}, (f32x2){u0[2], u0[3]}));
                    w[mm].y = pk4_fp8_raw(swiglu_pk((f32x2){g1[0], g1[1]}, (f32x2){u1[0], u1[1]}), swiglu_pk((f32x2){g1[2], g1[3]}, (f32x2){u1[2], u1[3]})); }
                const auto rx = __builtin_amdgcn_permlane16_swap(w[0].x, w[1].x, false, false); const auto ry = __builtin_amdgcn_permlane16_swap(w[0].y, w[1].y, false, false);
                u32x4 o; o.x = rx[0]; o.y = ry[0]; o.z = rx[1]; o.w = ry[1];
                *(u32x4*)(act + (size_t)(row0 + ai * HALF + (2 * mp + rsel) * 16) * 1024 + u.pn * HALF + wc * 32 + 8 * fqe) = o; }
    }
};
constexpr float YS_SCALE = 16.0f;
struct EpiScatter {
    static constexpr bool WIDE_N = false;
    static constexpr int PERM = 2;
    unsigned char* ys; float s;
    __device__ __forceinline__ void operator()(const f32x4 (&acc)[2][2][4][2], const Unit& u, int wr, int wc, int fr, int fq, PG8_LAS unsigned char* ldsx, int buf) const {
        const PG8_LAS int* ip = (const PG8_LAS int*)(ldsx + buf * 1024); const PG8_LAS float* ig = (const PG8_LAS float*)(ldsx + 3072 + buf * 1024);
        const int cl = wc * 64 + 16 * fq; const PG8_LAS float* bb = (const PG8_LAS float*)(ldsx + 6144 + buf * 1024) + cl;
#pragma unroll
        for (int ai = 0; ai < 2; ++ai)
#pragma unroll
            for (int m = 0; m < 4; ++m) { const int rr = ai * HALF + wr * 64 + m * 16 + fr; const int pair = ip[rr]; const float gate = ig[rr] * YS_SCALE;
                u32x4 w;
#pragma unroll
                for (int bj = 0; bj < 2; ++bj)
#pragma unroll
                    for (int n = 0; n < 2; ++n) { const f32x4 bvv = *(const PG8_LAS f32x4*)(bb + 8 * bj + 4 * n); const f32x4 v = (acc[ai][bj][m][n] * s + bvv) * gate; w[bj * 2 + n] = pk4_fp8(v[0], v[1], v[2], v[3]); }
                const unsigned off = (unsigned)pair * 1024u + (unsigned)(u.pn * BM + cl);
                asm volatile("global_store_dwordx4 %0, %1, %2" :: "v"(off), "v"(w), "s"(ys) : "memory"); }
    }
};

__device__ __forceinline__ void glds16s(unsigned voff, const char* base, unsigned ldsaddr) { unsigned keep;
    asm volatile("s_mov_b32 %0, m0\n\ts_mov_b32 m0, %3\n\ts_nop 0\n\tglobal_load_lds_dwordx4 %1, %2\n\ts_mov_b32 m0, %0" : "=&s"(keep) : "v"(voff), "s"(base), "s"(ldsaddr) : "memory"); }
template <class Epi, class Sched, bool ALIGN_EPI, bool FP8>
__device__ __forceinline__ void gemm_phase(PG8_LAS unsigned char* lds, PG8_LAS unsigned char* ldsx, const int nt, const int ldaB, const int ldbB, const Sched& S, const Epi& E) {
    int tid = threadIdx.x; asm volatile("" : "+v"(tid));
    const int wid = __builtin_amdgcn_readfirstlane(tid >> 6), lane = tid & 63, wr = wid >> 2, wc = wid & 3, fr = lane & 15, fq = lane >> 4;
    int R0, C0; stage_rc(tid * 16, R0, C0);
    unsigned vA[2][2], voffB[2];
#pragma unroll
    for (int i = 0; i < 2; ++i) { const int R = R0 + 64 * i;
        const int Rb = (Epi::PERM == 1) ? ((R & ~31) + perm32(R & 31)) : (Epi::PERM == 2) ? (64 * (R >> 5) + 16 * ((R & 15) >> 2) + 4 * ((R >> 4) & 1) + (R & 3)) : R;
        voffB[i] = (unsigned)(Rb * ldbB + C0 * 2); vA[0][i] = (unsigned)(R * ldaB + C0 * 2); vA[1][i] = (unsigned)((R + HALF) * ldaB + C0 * 2); }
    const size_t kstep = (size_t)(BK * 2);
    constexpr int H1 = (Sched::GATHER_A || Sched::ROWOFF_A) ? 1 : 0;
    const size_t hstepA = (Sched::GATHER_A || Sched::ROWOFF_A) ? (size_t)0 : (size_t)HALF * ldaB;
    const size_t hstepB = (size_t)(Epi::PERM == 2 ? 8 : HALF) * ldbB;
    const unsigned lds32 = (unsigned)(__UINTPTR_TYPE__)lds + (unsigned)wid * 1024u;
    const int aoff = lds_byte(wr * 64 + fr, fq * 8), boff = lds_byte(wc * 32 + fr, fq * 8);
#define PG8_SA(b, h) (((b) * 2 + (h)) * HTB)
#define PG8_SB(b, h) ((4 + (b) * 2 + (h)) * HTB)
#define PG8_STAGE(bufoff, gbase, voff) do { _Pragma("unroll") for (int _i = 0; _i < 2; ++_i) glds16s((voff)[_i], (const char*)(gbase), lds32 + (unsigned)((bufoff) + _i * 8192)); } while (0)
#define PG8_LD8(p) __builtin_shufflevector(*(const PG8_LAS v4i*)(p), *(const PG8_LAS v4i*)((p) + 1024), 0, 1, 2, 3, 4, 5, 6, 7)
#define PG8_LDA(dst, b, h) do { if constexpr (FP8) { _Pragma("unroll") for (int m = 0; m < 4; ++m) dst##8[m] = PG8_LD8(lds + PG8_SA(b, h) + aoff + m * 2048); } \
        else { _Pragma("unroll") for (int m = 0; m < 4; ++m) _Pragma("unroll") for (int k = 0; k < 2; ++k) dst[m][k] = *(const PG8_LAS bf16x8*)(lds + PG8_SA(b, h) + aoff + m * 2048 + k * 1024); } } while (0)
#define PG8_LDB(dst, b, h) do { if constexpr (FP8) { _Pragma("unroll") for (int n = 0; n < 2; ++n) dst##8[n] = PG8_LD8(lds + PG8_SB(b, h) + boff + n * 2048); } \
        else { _Pragma("unroll") for (int n = 0; n < 2; ++n) _Pragma("unroll") for (int k = 0; k < 2; ++k) dst[n][k] = *(const PG8_LAS bf16x8*)(lds + PG8_SB(b, h) + boff + n * 2048 + k * 1024); } } while (0)
#define PG8_MMA(ai, bj, At, Bt) do { __builtin_amdgcn_s_setprio(1); \
        if constexpr (FP8) { _Pragma("unroll") for (int m = 0; m < 4; ++m) _Pragma("unroll") for (int n = 0; n < 2; ++n) \
            acc[ai][bj][m][n] = __builtin_amdgcn_mfma_scale_f32_16x16x128_f8f6f4(Bt##8[n], At##8[m], acc[ai][bj][m][n], 0, 0, 0, 0, 0, 0); } \
        else { _Pragma("unroll") for (int m = 0; m < 4; ++m) _Pragma("unroll") for (int n = 0; n < 2; ++n) _Pragma("unroll") for (int k = 0; k < 2; ++k) \
            acc[ai][bj][m][n] = __builtin_amdgcn_mfma_f32_16x16x32_bf16(Bt[n][k], At[m][k], acc[ai][bj][m][n], 0, 0, 0); } \
        __builtin_amdgcn_s_setprio(0); } while (0)
#define PG8_WAIT_V(n) asm volatile("s_waitcnt vmcnt(" #n ")" ::: "memory")
#define PG8_WAIT_L(n) asm volatile("s_waitcnt lgkmcnt(" #n ")" ::: "memory")
#define PG8_BAR __builtin_amdgcn_s_barrier()
#define PG8_SCHED __builtin_amdgcn_sched_barrier(0)
#define PG8_GATHER(dst, buf) do { const PG8_LAS int* _ip = (const PG8_LAS int*)(ldsx + (buf) * 1024); _Pragma("unroll") for (int _h = 0; _h < 2; ++_h) _Pragma("unroll") for (int _i = 0; _i < 2; ++_i) \
        dst[_h][_i] = (unsigned)(_ip[_h * HALF + R0 + 64 * _i] >> 2) * (unsigned)ldaB + (unsigned)(C0 * 2); } while (0)
#define PG8_ROWOFF(dst, pmv) do { _Pragma("unroll") for (int _h = 0; _h < 2; ++_h) _Pragma("unroll") for (int _i = 0; _i < 2; ++_i) \
        dst[_h][_i] = (unsigned)((pmv) * BM + _h * HALF + R0 + 64 * _i) * (unsigned)ldaB + (unsigned)(C0 * 2); } while (0)
    Unit cur, nxt; int ui = 0, bcur = 0;
    if (!S.next(0, cur)) return;
    f32x4 acc[2][2][4][2];
#pragma unroll
    for (int a = 0; a < 2; ++a)
#pragma unroll
        for (int b = 0; b < 2; ++b)
#pragma unroll
            for (int m = 0; m < 4; ++m)
#pragma unroll
                for (int n = 0; n < 2; ++n) acc[a][b][m][n] = zero4();
    bf16x8 At[4][2], B0[2][2], B1[2][2]; v8i At8[4], B08[2], B18[2];
    const char* cA; const char* cB; S.ptrs(cur, cA, cB);
    const int kmask = nt - 1;
#define PG8_K0(u) ((Epi::WIDE_N ? (2 * (u).pm + (u).pn) : ((u).pm + 2 * (u).pn)) & kmask)
    int k0 = PG8_K0(cur);
    if constexpr (Sched::IDX) {
        S.issue_idx(cur, ldsx, 0, wid, lane);
        PG8_STAGE(PG8_SB(0, 0), cB + (size_t)k0 * kstep, voffB); PG8_STAGE(PG8_SB(0, 1), cB + hstepB + (size_t)k0 * kstep, voffB);
        PG8_WAIT_V(4); PG8_BAR; asm volatile("" ::: "memory");
        if constexpr (Sched::GATHER_A) { PG8_GATHER(vA, 0); PG8_WAIT_L(0); }
    }
    if constexpr (Sched::ROWOFF_A) { PG8_ROWOFF(vA, cur.pm); }
    { const size_t o0 = (size_t)k0 * kstep, o1 = (size_t)((k0 + 1) & kmask) * kstep;
    if constexpr (!Sched::IDX) { PG8_STAGE(PG8_SB(0, 0), cB + o0, voffB); PG8_STAGE(PG8_SB(0, 1), cB + hstepB + o0, voffB); }
    PG8_STAGE(PG8_SA(0, 0), cA + o0, vA[0]); PG8_STAGE(PG8_SA(0, 1), cA + hstepA + o0, vA[H1]);
    if (wr == 1) PG8_BAR;
    PG8_WAIT_V(2); PG8_BAR;
    PG8_STAGE(PG8_SB(1, 0), cB + o1, voffB); PG8_STAGE(PG8_SA(1, 0), cA + o1, vA[0]); PG8_STAGE(PG8_SB(1, 1), cB + hstepB + o1, voffB);
    PG8_WAIT_V(6); PG8_BAR; }
#pragma unroll 1
    for (;;) {
        const bool has_next = S.next(ui + 1, nxt);
        const int bnxt = (bcur == 2) ? 0 : bcur + 1;
        const char* nA = cA; const char* nB = cB;
        int k0n = k0;
        if (has_next) { S.ptrs(nxt, nA, nB); k0n = PG8_K0(nxt); if constexpr (Sched::IDX) S.issue_idx(nxt, ldsx, bnxt, wid, lane); }
#pragma unroll 1
        for (int t = 0; t < nt; t += 2) {
            const bool last = (t == nt - 2);
            const char* a1 = cA + (size_t)((t + 1 + k0) & kmask) * kstep;
            const size_t o2 = (size_t)((last ? k0n : t + 2 + k0) & kmask) * kstep, o3 = (size_t)((last ? k0n + 1 : t + 3 + k0) & kmask) * kstep;
            const char* a2 = (last ? nA : cA) + o2; const char* b2 = (last ? nB : cB) + o2;
            const char* a3 = (last ? nA : cA) + o3; const char* b3 = (last ? nB : cB) + o3;
            PG8_LDB(B0, 0, 0); PG8_LDB(B1, 0, 1); PG8_SCHED; PG8_LDA(At, 0, 0); PG8_STAGE(PG8_SA(1, 1), a1 + hstepA, vA[H1]);
            if constexpr (Sched::GATHER_A) { if (last && has_next) { PG8_GATHER(vA, bnxt); } }
            if constexpr (Sched::ROWOFF_A) { if (last && has_next) { PG8_ROWOFF(vA, nxt.pm); } }
            PG8_WAIT_V(8); PG8_WAIT_L(0); PG8_BAR; PG8_MMA(0, 0, At, B0); PG8_MMA(0, 1, At, B1); PG8_BAR; PG8_SCHED;
            PG8_LDA(At, 0, 1); PG8_STAGE(PG8_SB(0, 0), b2, voffB); PG8_STAGE(PG8_SB(0, 1), b2 + hstepB, voffB); PG8_STAGE(PG8_SA(0, 0), a2, vA[0]);
            PG8_WAIT_V(8); PG8_WAIT_L(0); PG8_BAR; PG8_MMA(1, 0, At, B0); PG8_MMA(1, 1, At, B1); PG8_BAR; PG8_SCHED;
            PG8_LDB(B0, 1, 0); PG8_LDB(B1, 1, 1); PG8_SCHED; PG8_LDA(At, 1, 0); PG8_STAGE(PG8_SA(0, 1), a2 + hstepA, vA[H1]);
            PG8_WAIT_V(8); PG8_WAIT_L(0); PG8_BAR; PG8_MMA(0, 0, At, B0); PG8_MMA(0, 1, At, B1); PG8_BAR; PG8_SCHED;
            PG8_LDA(At, 1, 1); PG8_STAGE(PG8_SB(1, 0), b3, voffB); PG8_STAGE(PG8_SB(1, 1), b3 + hstepB, voffB); PG8_STAGE(PG8_SA(1, 0), a3, vA[0]);
            PG8_WAIT_V(8); PG8_WAIT_L(0); PG8_BAR; PG8_MMA(1, 0, At, B0); PG8_MMA(1, 1, At, B1); PG8_BAR; PG8_SCHED;
        }
        if constexpr (ALIGN_EPI) { if (wr == 0) PG8_BAR; }
        { int tz = threadIdx.x; asm volatile("" : "+v"(tz));
          const int wid2 = __builtin_amdgcn_readfirstlane(tz >> 6), lane2 = tz & 63; E(acc, cur, wid2 >> 2, wid2 & 3, lane2 & 15, lane2 >> 4, ldsx, bcur); }
        if (!has_next) break;
#pragma unroll
        for (int a = 0; a < 2; ++a)
#pragma unroll
            for (int b = 0; b < 2; ++b)
#pragma unroll
                for (int m = 0; m < 4; ++m)
#pragma unroll
                    for (int n = 0; n < 2; ++n) acc[a][b][m][n] = zero4();
        cur = nxt; cA = nA; cB = nB; ++ui; bcur = bnxt; k0 = k0n;
        if constexpr (ALIGN_EPI) { if (wr == 1) PG8_BAR; }
    }
    PG8_WAIT_V(0);
    if constexpr (!ALIGN_EPI) { if (wr == 0) PG8_BAR; }
    PG8_BAR;
#undef PG8_SA
#undef PG8_SB
#undef PG8_STAGE
#undef PG8_LDA
#undef PG8_LDB
#undef PG8_MMA
#undef PG8_LD8
#undef PG8_WAIT_V
#undef PG8_WAIT_L
#undef PG8_BAR
#undef PG8_SCHED
#undef PG8_GATHER
#undef PG8_ROWOFF
#undef PG8_K0
}
}
#include <hip/hip_bf16.h>
#include <cmath>
namespace attn_body {
using bf16=__hip_bfloat16;
using bf16x8=__attribute__((ext_vector_type(8)))short;
using s16x4=__attribute__((ext_vector_type(4)))short;
using f32x16=__attribute__((ext_vector_type(16)))float;
using u32x4=__attribute__((ext_vector_type(4)))unsigned;
typedef float f32x4v __attribute__((ext_vector_type(4)));
constexpr int BATCH=4,NHEAD=16,SEQ=8192,D=64,DM=NHEAD*D;
constexpr int NW=8,QBLK=32,QB=QBLK*NW,KVBLK=64,NQB=SEQ/QB;
constexpr int ATTN_PITCH=DM, ATTN_UNIT_ROWS=QB;
__device__ __forceinline__ int crow(int r,int hi){return (r&3)+8*(r>>2)+4*hi;}
#define SBAR() __builtin_amdgcn_sched_barrier(0)
__device__ __forceinline__ void cmask(f32x16&p0,f32x16&p1,int jb,int qrel,int hi){
  const float NEG=-INFINITY; int kb=64*jb+4*hi;
  #pragma unroll
  for(int r=0;r<16;++r){int kv=kb+(r&3)+8*(r>>2); if(kv>qrel)p0[r]=NEG; if(kv+32>qrel)p1[r]=NEG;}
}

constexpr int NSLOT=3, SLOTB=8192;
constexpr int LDS_K=0, LDS_V=NSLOT*SLOTB, LDS_WS=2*NSLOT*SLOTB, LDS_OST=LDS_WS+NW*64*4, LDS_FB=LDS_OST+NW*4096, LDS_BYTES=LDS_FB+NW*1024;
constexpr float O_SCALE=16.0f;
constexpr float C2=0.125f*1.4426950408889634f;
__device__ __forceinline__ void glds16(const void*gsrc,unsigned lds_dst){unsigned keep;
  asm volatile("s_mov_b32 %0, m0\n\ts_mov_b32 m0, %2\n\ts_nop 0\n\tglobal_load_lds_dwordx4 %1, off\n\ts_mov_b32 m0, %0":"=&s"(keep):"v"(gsrc),"s"(lds_dst):"memory");}
__device__ __forceinline__ void glds4(const void*gsrc,unsigned lds_dst){unsigned keep;
  asm volatile("s_mov_b32 %0, m0\n\ts_mov_b32 m0, %2\n\ts_nop 0\n\tglobal_load_lds_dword %1, off\n\ts_mov_b32 m0, %0":"=&s"(keep):"v"(gsrc),"s"(lds_dst):"memory");}
__device__ __forceinline__ float max3f(float a,float b,float c){float r;asm("v_max3_f32 %0, %1, %2, %3":"=v"(r):"v"(a),"v"(b),"v"(c));return r;}
__device__ __forceinline__ float max2f(float a,float b){float r;asm("v_max_f32_e32 %0, %1, %2":"=v"(r):"v"(a),"v"(b));return r;}
__device__ __forceinline__ float fadd_s(float a,float b){float r;asm("v_add_f32_e32 %0, %1, %2":"=v"(r):"v"(a),"v"(b));return r;}
__device__ __forceinline__ float fsub_s(float a,float b){float r;asm("v_sub_f32_e32 %0, %1, %2":"=v"(r):"v"(a),"v"(b));return r;}
typedef float f32x2_t __attribute__((ext_vector_type(2))); typedef __bf16 bf16x2_t __attribute__((ext_vector_type(2)));
__device__ __forceinline__ unsigned cvtpk_s(float lo,float hi){f32x2_t v={lo,hi};bf16x2_t b=__builtin_convertvector(v,bf16x2_t);return __builtin_bit_cast(unsigned,b);}
#define WAIT_BAR(N) asm volatile("s_waitcnt vmcnt(" #N ") lgkmcnt(0)\n\ts_barrier":::"memory")

__device__ __forceinline__ void qkt(f32x16&p0,f32x16&p1,const char*Kslot,const bf16x8*qr,int r32,int hi){ const f32x16 negm=f32x16{};
  const char*kb=Kslot+hi*1024+r32*16;
  #pragma unroll
  for(int d0=0;d0<4;++d0){
    const bf16x8 b0=*reinterpret_cast<const bf16x8*>(kb+d0*2048);
    const bf16x8 b1=*reinterpret_cast<const bf16x8*>(kb+d0*2048+512);
    if(d0==0){p0=__builtin_amdgcn_mfma_f32_32x32x16_bf16(b0,qr[0],negm,0,0,0);p1=__builtin_amdgcn_mfma_f32_32x32x16_bf16(b1,qr[0],negm,0,0,0);}
    else{p0=__builtin_amdgcn_mfma_f32_32x32x16_bf16(b0,qr[d0],p0,0,0,0);p1=__builtin_amdgcn_mfma_f32_32x32x16_bf16(b1,qr[d0],p1,0,0,0);}}
}
typedef __attribute__((address_space(3))) const char* lds_cptr;
typedef short v4i16_t __attribute__((ext_vector_type(4)));
__device__ __forceinline__ void kload8(bf16x8*kf,lds_cptr kp){
  kf[0]=*(const __attribute__((address_space(3))) bf16x8*)(kp);      kf[1]=*(const __attribute__((address_space(3))) bf16x8*)(kp+512);
  kf[2]=*(const __attribute__((address_space(3))) bf16x8*)(kp+2048); kf[3]=*(const __attribute__((address_space(3))) bf16x8*)(kp+2560);
  kf[4]=*(const __attribute__((address_space(3))) bf16x8*)(kp+4096); kf[5]=*(const __attribute__((address_space(3))) bf16x8*)(kp+4608);
  kf[6]=*(const __attribute__((address_space(3))) bf16x8*)(kp+6144); kf[7]=*(const __attribute__((address_space(3))) bf16x8*)(kp+6656);
}
__device__ __forceinline__ void kload2(bf16x8*kf,lds_cptr kp,int j){ kf[2*j]=*(const __attribute__((address_space(3))) bf16x8*)(kp+j*2048); kf[2*j+1]=*(const __attribute__((address_space(3))) bf16x8*)(kp+j*2048+512); }
__device__ __forceinline__ s16x4 vtr(lds_cptr p){ return __builtin_bit_cast(s16x4,__builtin_amdgcn_ds_read_tr16_b64_v4i16((__attribute__((address_space(3))) v4i16_t*)p)); }
__device__ __forceinline__ float rowmax(const f32x16&p0,const f32x16&p1){
  float a=max3f(p0[0],p0[1],p1[0]),b=max3f(p0[2],p0[3],p1[1]);a=max3f(a,p1[2],p1[3]);
  #pragma unroll
  for(int r=4;r<16;r+=4){a=max3f(a,p0[r],p0[r+1]);b=max3f(b,p0[r+2],p0[r+3]);a=max3f(a,p1[r],p1[r+1]);b=max3f(b,p1[r+2],p1[r+3]);}
  const float m=max2f(a,b);
  auto rr=__builtin_amdgcn_permlane32_swap(__float_as_uint(m),__float_as_uint(m),false,false);
  return max2f(__uint_as_float(rr[0]),__uint_as_float(rr[1]));
}
__device__ __forceinline__ void pv(f32x16*o,int vb,bf16x8 pa0,bf16x8 pa1,bf16x8 pa2,bf16x8 pa3){
  #pragma unroll
  for(int d0=0;d0<2;++d0){s16x4 lo[4],hi[4];
    #pragma unroll
    for(int ks=0;ks<4;++ks){
      asm volatile("ds_read_b64_tr_b16 %0,%1 offset:%c2":"=&v"(lo[ks]):"v"(vb),"i"(d0*4096+ks*1024):"memory");
      asm volatile("ds_read_b64_tr_b16 %0,%1 offset:%c2":"=&v"(hi[ks]):"v"(vb),"i"(d0*4096+ks*1024+512):"memory");}
    asm volatile("s_waitcnt lgkmcnt(0)":::"memory");SBAR();
    #define PK(k) (bf16x8){lo[k][0],lo[k][1],lo[k][2],lo[k][3],hi[k][0],hi[k][1],hi[k][2],hi[k][3]}
    o[d0]=__builtin_amdgcn_mfma_f32_32x32x16_bf16(pa0,PK(0),o[d0],0,0,0);
    o[d0]=__builtin_amdgcn_mfma_f32_32x32x16_bf16(pa1,PK(1),o[d0],0,0,0);
    o[d0]=__builtin_amdgcn_mfma_f32_32x32x16_bf16(pa2,PK(2),o[d0],0,0,0);
    o[d0]=__builtin_amdgcn_mfma_f32_32x32x16_bf16(pa3,PK(3),o[d0],0,0,0);
    #undef PK
  }
}

__device__ __forceinline__ int attn_j0(int b,int h,int qb,const float*__restrict__ FB,const unsigned*__restrict__ QN2,const unsigned*__restrict__ KN2,int lane){
  const int q0=qb*QB; const float* FBs=FB+((long)b*NHEAD+h)*SEQ; const int NT0=(q0+QB)/KVBLK;
  const unsigned*qp_=QN2+((b*NHEAD+h)*NQB+qb)*2,*kp_=KN2+(b*NHEAD+h)*2;
  const float qn=sqrtf(__uint_as_float(qp_[0])+__uint_as_float(qp_[1])), kn=sqrtf(__uint_as_float(kp_[0])+__uint_as_float(kp_[1]));
  const float thr=2.0f*qn*kn*1.02f+40.0f, fq0=FBs[q0];
  const int ja=lane, jb2=lane+64;
  const bool sa=(ja<NT0)&&(fq0-FBs[ja*KVBLK+KVBLK-1]>thr), sb=(jb2<NT0)&&(fq0-FBs[jb2*KVBLK+KVBLK-1]>thr);
  int j0=__builtin_popcountll(__ballot(sa))+__builtin_popcountll(__ballot(sb)); j0&=~1; if(j0>NT0-4)j0=NT0-4; return j0;
}
#ifndef ATTN_STORE16
#define ATTN_STORE16(p,v) (*(u32x4*)(p)=(v))
#endif
template<int THRL> __device__ __forceinline__ void attn_unit(int b,int h,int qb,const bf16*Q,const bf16*__restrict__ K,const bf16*__restrict__ V,bf16*O,const float*__restrict__ FB,int j0_in,char*shm,
                                                             bool pre,bool has_next,int nb,int nh,int nqb,int nj0,bf16x8 (&qr)[4]){
  int tid=threadIdx.x; asm volatile("":"+v"(tid)); const int lane=tid&63,r32=lane&31,hi=lane>>5; const int wid=__builtin_amdgcn_readfirstlane(tid>>6);
  const long rowbase=(long)b*SEQ; const int q0=qb*QB;
  const bf16*Qw=Q+(rowbase+q0+wid*QBLK)*DM+h*D;
  const int j0=j0_in;
  const bf16*Kh=K+(rowbase+(long)j0*KVBLK)*DM+h*D,*Vh=V+(rowbase+(long)j0*KVBLK)*DM+h*D;
  const unsigned lds0=(unsigned)(uintptr_t)shm;
  float*wsf=(float*)(shm+LDS_WS)+wid*64;
  const bf16*ksrc=Kh+(long)lane*DM+wid*8;
  const bf16*vsrc=Vh+(long)(16*(wid&3)+(lane>>2))*DM+(wid>>2)*32+(lane&3)*8;
  const unsigned kdst=lds0+LDS_K+wid*1024, vdst=lds0+LDS_V+wid*1024;
  const float*fbsrc=FB+((long)b*NHEAD+h)*SEQ+(long)j0*KVBLK+lane; const unsigned fbdst=lds0+LDS_FB+wid*1024;
  #define DMA_K(t,slot) do{ glds16(ksrc+(long)(t)*KVBLK*DM,(unsigned)__builtin_amdgcn_readfirstlane(kdst+(slot))); glds4(fbsrc+(long)(t)*KVBLK,(unsigned)__builtin_amdgcn_readfirstlane(fbdst+(((t)&3)<<8))); }while(0)
  #define DMA_V(t,slot) glds16(vsrc+(long)(t)*KVBLK*DM,(unsigned)__builtin_amdgcn_readfirstlane(vdst+(slot)))
  const int vb0=(int)(lds0+LDS_V)+((lane>>4)&1)*32+(lane&3)*8+(4*hi+((lane&15)>>2))*64;
  const char*Kbase=shm+LDS_K; bf16x8 kf[8];
  const lds_cptr shm3=(lds_cptr)shm; const lds_cptr kp0=shm3+LDS_K+hi*1024+r32*16; const lds_cptr vp0=shm3+LDS_V+((lane>>4)&1)*32+(lane&3)*8+(4*hi+((lane&15)>>2))*64;
  const int NT=(q0+QB)/KVBLK-j0;
  if(!pre){ DMA_K(0,0);DMA_V(0,0);DMA_K(1,SLOTB); }
  if(!pre){
    #pragma unroll
    for(int d0=0;d0<4;++d0)qr[d0]=*reinterpret_cast<const bf16x8*>(&Qw[(long)r32*DM+d0*16+hi*8]); }
  float mhat=0.f,l_reg=0.f;f32x16 o[2];
  _Pragma("unroll") for(int d_=0;d_<2;++d_) _Pragma("unroll") for(int r=0;r<16;++r){ float z_; asm volatile("v_mov_b32 %0, 0":"=v"(z_)); o[d_][r]=z_; }
  const int qrel=wid*QBLK+r32;
  #define CMASK(P0,P1,t) do{int jb_=(t)-(NT-4); if(jb_>=0)cmask(P0,P1,jb_,qrel,hi);}while(0)
  const unsigned hmask=hi?0u:0xffffffffu, c3f=0x3F803F80u&hmask;
  u32x4 mqw; mqw[0]=c3f; mqw[1]=0x3F80u&hmask; mqw[2]=0u; mqw[3]=0u;
  const __attribute__((address_space(3))) float* fbw=(const __attribute__((address_space(3))) float*)(shm3+LDS_FB+wid*1024)+r32;
  #define SETMQ() do{ const float nm_=-mhat; const unsigned u1_=__float_as_uint(nm_)&0xffff0000u; const float q1_=nm_-__uint_as_float(u1_); const unsigned u2_=__float_as_uint(q1_)&0xffff0000u; \
      const float q2_=q1_-__uint_as_float(u2_); const unsigned u3_=__float_as_uint(q2_)&0xffff0000u; mqw[1]=(0x3F80u|u1_)&hmask; mqw[2]=((u2_>>16)|u3_)&hmask; }while(0)
  #define BFRAG(dst,bv) do{ const unsigned u1_=__float_as_uint(bv)&0xffff0000u; const float q1_=(bv)-__uint_as_float(u1_); const unsigned u2_=__float_as_uint(q1_)&0xffff0000u; \
      const float q2_=q1_-__uint_as_float(u2_); const unsigned u3_=__float_as_uint(q2_)>>16; dst[0]=((u1_>>16)|u2_)&hmask; dst[1]=(u3_|0x3F800000u)&hmask; dst[2]=c3f; dst[3]=0u; }while(0)
  #define KBIAS(P0,P1,t) do{ const float bq0_=fbw[(((t)&3)<<6)], bq1_=fbw[(((t)&3)<<6)+32]; u32x4 ba_; \
      BFRAG(ba_,bq0_); P0=__builtin_amdgcn_mfma_f32_32x32x16_bf16(__builtin_bit_cast(bf16x8,ba_),__builtin_bit_cast(bf16x8,mqw),P0,0,0,0); \
      BFRAG(ba_,bq1_); P1=__builtin_amdgcn_mfma_f32_32x32x16_bf16(__builtin_bit_cast(bf16x8,ba_),__builtin_bit_cast(bf16x8,mqw),P1,0,0,0); }while(0)
  bool resc=false;
  #define START(P0,P1) do{ const float rm=rowmax(P0,P1); resc=false; \
    { const float dl=rm; mhat=fadd_s(mhat,dl); \
      _Pragma("unroll") for(int r=0;r<16;++r){P0[r]=fsub_s(P0[r],dl);P1[r]=fsub_s(P1[r],dl);} \
      SETMQ(); } \
    _Pragma("unroll") for(int r=0;r<16;++r)P0[r]=__builtin_amdgcn_exp2f(P0[r]); }while(0)
  #define RESC() do{ if(resc){ asm volatile("s_waitcnt lgkmcnt(0)":::"memory"); \
      _Pragma("unroll") for(int d_=0;d_<2;++d_) _Pragma("unroll") for(int r=0;r<16;++r)o[d_][r]*=wsf[crow(r,hi)]; } }while(0)
  f32x16 pA0,pA1,pB0,pB1;
  int sl_prev=0,sl_cur=0,sl_next=SLOTB;
  #define ROT() do{sl_prev=sl_cur;sl_cur=sl_next;sl_next=(sl_next==(NSLOT-1)*SLOTB)?0:sl_next+SLOTB;}while(0)
  if(!pre){ DMA_K(2,2*SLOTB); }
  WAIT_BAR(5);
  qkt(pA0,pA1,Kbase,qr,r32,hi);KBIAS(pA0,pA1,0);asm volatile("s_nop 15\n\ts_nop 7":"+v"(pA0),"+v"(pA1));CMASK(pA0,pA1,0);
  START(pA0,pA1);
  _Pragma("unroll") for(int r=0;r<16;++r)pA1[r]=__builtin_amdgcn_exp2f(pA1[r]);
  WAIT_BAR(0);
  DMA_K(3,0);DMA_V(1,SLOTB);
  ROT();
  kload8(kf,kp0+sl_cur);
  WAIT_BAR(3);
  s16x4 vlo[8],vhi[8]; u32x4 pw0,pw1,pw2,pw3;
  #define PKW(P,B) cvtpk_s(P[B],P[B+1])
  #define PAF(k) __builtin_bit_cast(bf16x8,pw##k)
  #define VFR(i) (bf16x8){vlo[i][0],vlo[i][1],vlo[i][2],vlo[i][3],vhi[i][0],vhi[i][1],vhi[i][2],vhi[i][3]}
  #define PIN(x) asm volatile("":"+v"(x))
  #define MX3(a,b,c) __builtin_fmaxf(__builtin_fmaxf((a),(b)),(c))
  #define GAPA(MF,A0,A1,A2,A3,W0,W1,PW) do{ MF; sacc+=A0; sacc+=A1; sacc+=A2; sacc+=A3; PIN(sacc); W0; W1; PIN(PW); SBAR(); }while(0)
  #define EX(v) __builtin_amdgcn_exp2f(v)
  #define GAPB(MF,X,B) do{ MF; X[B]=EX(X[B]); X[B+1]=EX(X[B+1]); X[B+2]=EX(X[B+2]); X[B+3]=EX(X[B+3]); PIN(X); SBAR(); }while(0)
  #define VRD(i) do{ vlo[i]=vtr(vp_+(((i)>>2)*4096+((i)&3)*1024)); vhi[i]=vtr(vp_+(((i)>>2)*4096+((i)&3)*1024+512)); }while(0)
  #define KRD(G,j) do{ if(G){ kload2(kf,kp0+sl_next,j); SBAR(); } }while(0)
  #define STEP(C0,C1,P0,P1,t,GK,GV,GL) do{ SBAR(); \
    const lds_cptr vp_=vp0+sl_prev; \
    VRD(0); SBAR(); float sacc=(P0[0]+P0[1]); \
    GAPA(C0=__builtin_amdgcn_mfma_f32_32x32x16_bf16(kf[0],qr[0],f32x16{},0,0,0), P0[2],P0[3],P0[4],P0[5],     pw0[0]=PKW(P0,0), pw0[1]=PKW(P0,2), pw0); \
    VRD(4); SBAR(); GAPA(C1=__builtin_amdgcn_mfma_f32_32x32x16_bf16(kf[1],qr[0],f32x16{},0,0,0), P0[6],P0[7],P0[8],P0[9],     pw0[2]=PKW(P0,4), pw0[3]=PKW(P0,6), pw0); \
    VRD(1); SBAR(); GAPA(C0=__builtin_amdgcn_mfma_f32_32x32x16_bf16(kf[2],qr[1],C0,0,0,0),   P0[10],P0[11],P0[12],P0[13], pw1[0]=PKW(P0,8), pw1[1]=PKW(P0,10), pw1); \
    VRD(5); SBAR(); GAPA(C1=__builtin_amdgcn_mfma_f32_32x32x16_bf16(kf[3],qr[1],C1,0,0,0),   P0[14],P0[15],P1[0],P1[1],   pw1[2]=PKW(P0,12),pw1[3]=PKW(P0,14), pw1); \
    VRD(2); SBAR(); GAPA(C0=__builtin_amdgcn_mfma_f32_32x32x16_bf16(kf[4],qr[2],C0,0,0,0),   P1[2],P1[3],P1[4],P1[5],     pw2[0]=PKW(P1,0), pw2[1]=PKW(P1,2), pw2); \
    VRD(6); SBAR(); GAPA(C1=__builtin_amdgcn_mfma_f32_32x32x16_bf16(kf[5],qr[2],C1,0,0,0),   P1[6],P1[7],P1[8],P1[9],     pw2[2]=PKW(P1,4), pw2[3]=PKW(P1,6), pw2); \
    VRD(3); SBAR(); GAPA(C0=__builtin_amdgcn_mfma_f32_32x32x16_bf16(kf[6],qr[3],C0,0,0,0),   P1[10],P1[11],P1[12],P1[13], pw3[0]=PKW(P1,8), pw3[1]=PKW(P1,10), pw3); \
    VRD(7); SBAR(); GAPA(C1=__builtin_amdgcn_mfma_f32_32x32x16_bf16(kf[7],qr[3],C1,0,0,0),   P1[14],P1[15],0.f,0.f,       pw3[2]=PKW(P1,12),pw3[3]=PKW(P1,14), pw3); \
    KBIAS(C0,C1,t); SBAR(); l_reg+=sacc; \
    if(GK){DMA_K((t)+3,sl_cur);} if(GV){DMA_V((t)+1,sl_next);} \
    CMASK(C0,C1,t); \
    { float a=MX3(C0[0],C0[1],C1[0]),b=MX3(C0[2],C0[3],C1[1]); a=MX3(a,C1[2],C1[3]); \
      _Pragma("unroll") for(int r=4;r<16;r+=4){a=MX3(a,C0[r],C0[r+1]);b=MX3(b,C0[r+2],C0[r+3]);a=MX3(a,C1[r],C1[r+1]);b=MX3(b,C1[r+2],C1[r+3]);} \
      float rm=__builtin_fmaxf(a,b); { auto rr=__builtin_amdgcn_permlane32_swap(__float_as_uint(rm),__float_as_uint(rm),false,false); rm=__builtin_fmaxf(__uint_as_float(rr[0]),__uint_as_float(rr[1])); } \
      resc=false; \
      if(__builtin_expect(__any(rm>(float)THRL),0)){ const float dl=__builtin_fmaxf(rm,0.f); mhat+=dl; \
        _Pragma("unroll") for(int r=0;r<16;++r){C0[r]-=dl;C1[r]-=dl;} \
        SETMQ(); \
        const float f=__builtin_amdgcn_exp2f(-dl); l_reg*=f; if(hi==0)wsf[r32]=f; resc=true; } } \
    SBAR(); \
    GAPB(o[0]=__builtin_amdgcn_mfma_f32_32x32x16_bf16(PAF(0),VFR(0),o[0],0,0,0), C0,0); \
    GAPB(o[1]=__builtin_amdgcn_mfma_f32_32x32x16_bf16(PAF(0),VFR(4),o[1],0,0,0), C0,4); \
    KRD(GL,0); GAPB(o[0]=__builtin_amdgcn_mfma_f32_32x32x16_bf16(PAF(1),VFR(1),o[0],0,0,0), C0,8); \
    KRD(GL,1); GAPB(o[1]=__builtin_amdgcn_mfma_f32_32x32x16_bf16(PAF(1),VFR(5),o[1],0,0,0), C0,12); \
    KRD(GL,2); GAPB(o[0]=__builtin_amdgcn_mfma_f32_32x32x16_bf16(PAF(2),VFR(2),o[0],0,0,0), C1,0); \
    KRD(GL,3); GAPB(o[1]=__builtin_amdgcn_mfma_f32_32x32x16_bf16(PAF(2),VFR(6),o[1],0,0,0), C1,4); \
    GAPB(o[0]=__builtin_amdgcn_mfma_f32_32x32x16_bf16(PAF(3),VFR(3),o[0],0,0,0), C1,8); \
    GAPB(o[1]=__builtin_amdgcn_mfma_f32_32x32x16_bf16(PAF(3),VFR(7),o[1],0,0,0), C1,12); \
    }while(0)
  int t=1;
  #undef CMASK
  #define CMASK(P0,P1,t) do{}while(0)
  for(;t+5<NT;t+=2){
    STEP(pB0,pB1,pA0,pA1,t,true,true,true);     WAIT_BAR(3); RESC(); ROT();
    STEP(pA0,pA1,pB0,pB1,t+1,true,true,true);   WAIT_BAR(3); RESC(); ROT();
  }
  #undef CMASK
  #define CMASK(P0,P1,t) do{int jb_=(t)-(NT-4); if(jb_>=0)cmask(P0,P1,jb_,qrel,hi);}while(0)
  #define ENDW(tt) do{ if((tt)+3<NT){WAIT_BAR(3);} else if((tt)+2<NT){WAIT_BAR(1);} else {WAIT_BAR(0);} }while(0)
  for(;t+1<NT;t+=2){
    STEP(pB0,pB1,pA0,pA1,t,(t+3<NT),(t+1<NT),(t+1<NT));       ENDW(t);   RESC(); ROT();
    STEP(pA0,pA1,pB0,pB1,t+1,(t+4<NT),(t+2<NT),(t+2<NT));     ENDW(t+1); RESC(); ROT();
  }
  STEP(pB0,pB1,pA0,pA1,NT-1,false,false,false); RESC();
  { float sacc=pB0[0]+pB0[1]; _Pragma("unroll") for(int r=2;r<16;++r)sacc+=pB0[r]; _Pragma("unroll") for(int r=0;r<16;++r)sacc+=pB1[r]; l_reg+=sacc;
    pw0=(u32x4){PKW(pB0,0),PKW(pB0,2),PKW(pB0,4),PKW(pB0,6)};pw1=(u32x4){PKW(pB0,8),PKW(pB0,10),PKW(pB0,12),PKW(pB0,14)};pw2=(u32x4){PKW(pB1,0),PKW(pB1,2),PKW(pB1,4),PKW(pB1,6)};pw3=(u32x4){PKW(pB1,8),PKW(pB1,10),PKW(pB1,12),PKW(pB1,14)};
    SBAR(); pv(o,vb0+sl_cur,PAF(0),PAF(1),PAF(2),PAF(3)); }
  #undef PKW
  #undef PAF
  #undef VFR
  #undef PIN
  #undef MX3
  #undef GAPA
  #undef GAPB
  #undef EX
  #undef VRD
  #undef KRD
  #undef STEP
  #undef ENDW
  asm volatile("s_waitcnt lgkmcnt(0)\n\ts_barrier":::"memory");
  if(has_next){
    const long nrowbase=(long)nb*SEQ; const int nq0=nqb*QB;
    const bf16*nKh=K+(nrowbase+(long)nj0*KVBLK)*DM+nh*D,*nVh=V+(nrowbase+(long)nj0*KVBLK)*DM+nh*D;
    const bf16*nks=nKh+(long)lane*DM+wid*8; const bf16*nvs=nVh+(long)(16*(wid&3)+(lane>>2))*DM+(wid>>2)*32+(lane&3)*8;
    const float*nfb=FB+((long)nb*NHEAD+nh)*SEQ+(long)nj0*KVBLK+lane;
    #define NDMA_K(t,slot) do{ glds16(nks+(long)(t)*KVBLK*DM,(unsigned)__builtin_amdgcn_readfirstlane(kdst+(slot))); glds4(nfb+(long)(t)*KVBLK,(unsigned)__builtin_amdgcn_readfirstlane(fbdst+(((t)&3)<<8))); }while(0)
    NDMA_K(0,0); glds16(nvs,(unsigned)__builtin_amdgcn_readfirstlane(vdst)); NDMA_K(1,SLOTB); NDMA_K(2,2*SLOTB);
    #undef NDMA_K
    const bf16*nQw=Q+(nrowbase+nq0+wid*QBLK)*DM+nh*D;
    #pragma unroll
    for(int d0=0;d0<4;++d0)qr[d0]=*reinterpret_cast<const bf16x8*>(&nQw[(long)r32*DM+d0*16+hi*8]);
  }
  {auto rr=__builtin_amdgcn_permlane32_swap(__float_as_uint(l_reg),__float_as_uint(l_reg),false,false);l_reg=__uint_as_float(rr[0])+__uint_as_float(rr[1]);}
  if(hi==0)wsf[32+r32]=l_reg;asm volatile("s_waitcnt lgkmcnt(0)":::"memory");
  float rli[16];
  #pragma unroll
  for(int r=0;r<16;++r)rli[r]=__builtin_amdgcn_rcpf(wsf[32+crow(r,hi)]);
  unsigned char*Ow=(unsigned char*)O+(rowbase+q0+wid*QBLK)*DM+h*D;
  { unsigned char*stg=(unsigned char*)(shm+LDS_OST)+wid*4096;
    #pragma unroll
    for(int r=0;r<16;++r){const int orow=crow(r,hi); const float sc_=rli[r]*O_SCALE;
      #pragma unroll
      for(int d0=0;d0<2;++d0){ const float x_=__builtin_amdgcn_fmed3f(o[d0][r]*sc_,-448.0f,448.0f); int w_; asm volatile("v_mov_b32 %0, 0":"=v"(w_)); w_=__builtin_amdgcn_cvt_pk_fp8_f32(x_,x_,w_,false); stg[orow*64+d0*32+r32]=(unsigned char)w_; } }
    asm volatile("s_waitcnt lgkmcnt(0)":::"memory");
    #pragma unroll
    for(int i=0;i<2;++i){const int row=i*16+(lane>>2),ch=lane&3; const u32x4 v=*(const u32x4*)(stg+row*64+ch*16); ATTN_STORE16(Ow+(long)row*DM+ch*16,v);} }
  asm volatile("s_waitcnt lgkmcnt(0)":::"memory");
  #undef DMA_K
  #undef DMA_V
  #undef KBIAS
  #undef BFRAG
  #undef SETMQ
  #undef CMASK
  #undef START
  #undef RESC
  #undef ROT
}
constexpr int ATTN_LDS_BYTES=LDS_BYTES;
struct AttnTensors { const bf16* Q; const bf16* K; const bf16* V; bf16* O; const float* FB; const unsigned* QN2; const unsigned* KN2; };
struct AttnUnit { int bh; int qb; };
struct StaticOrder {
  int vcu;
  __device__ __forceinline__ explicit StaticOrder(int grid,int block):vcu((block%8)*(grid/8)+block/8){}
  __device__ __forceinline__ bool next(int i,AttnUnit&u)const{ if(i>=8)return false; const int s=vcu&7,j=i&3; u.bh=(vcu>>3)+32*(i>>2); u.qb=(j==0)?s:(j==1)?15-s:(j==2)?16+s:31-s; return true; }
  __device__ __forceinline__ void a_ready(const AttnUnit&)const{}
  __device__ __forceinline__ void done(const AttnUnit&)const{}
};
template<class Sched,int THRL=8> __device__ __forceinline__ void attn_phase(char*lds,const AttnTensors&T,const Sched&S,volatile __attribute__((address_space(3))) int*j0buf){
  AttnUnit u;
  { int tid=threadIdx.x; asm volatile("":"+v"(tid)); const int lane=tid&63,wid=__builtin_amdgcn_readfirstlane(tid>>6);
    if(S.next(wid,u)){ const int j=attn_j0(u.bh/NHEAD,u.bh%NHEAD,u.qb,T.FB,T.QN2,T.KN2,lane); if(lane==0)j0buf[wid]=j; }
    asm volatile("s_waitcnt lgkmcnt(0)\n\ts_barrier":::"memory"); }
  bf16x8 qr[4]; bool pre=false;
  #pragma unroll 1
  for(int i=0;S.next(i,u);++i){ S.a_ready(u); AttnUnit un; const bool hn=S.next(i+1,un); const int nj0=hn?__builtin_amdgcn_readfirstlane(j0buf[i+1]):0;
    attn_unit<THRL>(u.bh/NHEAD,u.bh%NHEAD,u.qb,T.Q,T.K,T.V,T.O,T.FB,__builtin_amdgcn_readfirstlane(j0buf[i]),lds,pre,hn,un.bh/NHEAD,un.bh%NHEAD,un.qb,nj0,qr); pre=hn; S.done(u); }
}
#undef SBAR
#undef WAIT_BAR
}
constexpr int NWAVES = 8;
constexpr size_t MiB = 1u << 20;
constexpr size_t WS_CTL = 0, CTL_ZERO_BYTES = 1 * MiB;
constexpr size_t WS_MODV = 1 * MiB;
constexpr size_t WS_R1 = 2 * MiB;
constexpr size_t WS_LF = 3 * MiB, WS_FB = 5 * MiB;
constexpr size_t WS_SLOTP = 8 * MiB, WS_SLOTG = 12 * MiB;
constexpr size_t WS_WPOOL = 16 * MiB, WS_WO = 18 * MiB, WS_WQKV = 22 * MiB;
constexpr size_t WS_HB = 64 * MiB;
constexpr size_t WS_Q = 128 * MiB, WS_K = 192 * MiB, WS_V = 256 * MiB;
constexpr size_t WS_YS = 320 * MiB;
constexpr size_t WS_ACT = 576 * MiB;
constexpr size_t WS_W2 = 848 * MiB, WS_W1 = 1104 * MiB;
constexpr size_t WS_XB = 1616 * MiB, WS_END = 1680 * MiB;
static_assert(WS_ACT + (size_t)MAXMT * 256 * 1024 * 2 <= WS_W2 && WS_W1 + (size_t)DEPTH * NEXP * 2048 * 1024 * 2 <= WS_XB && WS_XB + (size_t)T * D * 2 <= WS_END, "d_ws map");
constexpr int CW_TMO = 0, CW_CODE = 1, CW_BAR = 4096, CW_GCNT = 8192, CW_KN2 = 8448, CW_QN2 = 8704;
constexpr int RING_OFF = 0, RING_BYTES = 131072;
constexpr int IDX_OFF = RING_BYTES;
constexpr int SCHED_OFF = IDX_OFF + pg8::IDX_BYTES;
constexpr int MISC_OFF = SCHED_OFF + 1024;
constexpr int LDS_BYTES = 147456;
static_assert(MISC_OFF + 128 <= LDS_BYTES, "LDS map");

typedef unsigned short bf16;
typedef unsigned v4u __attribute__((ext_vector_type(4)));
typedef unsigned v2u __attribute__((ext_vector_type(2)));
typedef float f32x4 __attribute__((ext_vector_type(4)));
typedef GAS unsigned gu32;
#define RLX_AGENT __ATOMIC_RELAXED, __HIP_MEMORY_SCOPE_AGENT
#define LDS_WAIT() asm volatile("s_waitcnt lgkmcnt(0)" ::: "memory")
#define VM_WAIT() asm volatile("s_waitcnt vmcnt(0)" ::: "memory")
__device__ __forceinline__ unsigned f2bf(float f) { unsigned u = __builtin_bit_cast(unsigned, f); return (u + 0x7fffu + ((u >> 16) & 1u)) >> 16; }
__device__ __forceinline__ unsigned pk2(float lo, float hi) { return f2bf(lo) | (f2bf(hi) << 16); }
__device__ __forceinline__ float bflo(unsigned u) { return __builtin_bit_cast(float, u << 16); }
__device__ __forceinline__ float bfhi(unsigned u) { return __builtin_bit_cast(float, u & 0xffff0000u); }
template <bool BF> __device__ __forceinline__ f32x4 ldx4(const void* base, size_t eoff) {
    if (BF) { const v2u w = *(const GAS v2u*)((const bf16*)base + eoff); return (f32x4){bflo(w.x), bfhi(w.x), bflo(w.y), bfhi(w.y)}; }
    return *(const GAS f32x4*)((const float*)base + eoff);
}
__device__ __forceinline__ void stx4_bf(bf16* base, size_t eoff, f32x4 v) { v2u o; o.x = pk2(v.x, v.y); o.y = pk2(v.z, v.w); *(GAS v2u*)(base + eoff) = o; }
#define XB_TMO      128
#define XB_XCNT(j)  (256  + 64 * (j))
#define XB_XSUB(j)  (1280 + 64 * (j))
#define XB_XGEN(j)  (2304 + 64 * (j))
#define XB_TOP      3328
#define XB_TOPGEN   3392
#define XCD_BAR_WORDS 3456
#define XB_SPIN_CAP (1u << 18)

__device__ __forceinline__ unsigned xb_ld(unsigned* p)              { return __hip_atomic_load(p, __ATOMIC_RELAXED, __HIP_MEMORY_SCOPE_AGENT); }
__device__ __forceinline__ unsigned xb_add(unsigned* p, unsigned v) { return __hip_atomic_fetch_add(p, v, __ATOMIC_RELAXED, __HIP_MEMORY_SCOPE_AGENT); }
__device__ __forceinline__ unsigned xb_xcc_id() { return (unsigned)__builtin_amdgcn_s_getreg((3 << 11) | 20) & 0xFu; }
#define XB_SPIN(cond, bar) do { unsigned _sp = 0; while (cond) { __builtin_amdgcn_s_sleep(1); \
    if ((++_sp & 255u) == 0u) { if (xb_ld(&(bar)[XB_TMO])) break; if (_sp > XB_SPIN_CAP) { atomicAdd(&(bar)[XB_TMO], 1u); break; } } } } while (0)

struct XcdBarrier {
    unsigned* bar; unsigned x;
    volatile LAS unsigned* st;
};

__device__ __forceinline__ XcdBarrier xcd_barrier_post(unsigned* bar, volatile LAS unsigned* st) {
    XcdBarrier b; b.bar = bar; b.x = xb_xcc_id(); b.st = st;
    if (threadIdx.x == 0) (void)xb_add(&bar[XB_XCNT(b.x)], 1u);
    return b;
}
__device__ __forceinline__ void xcd_barrier_complete(unsigned* bar, unsigned x, unsigned& nloc, unsigned& nx) {
    const unsigned G = gridDim.x * gridDim.y * gridDim.z;
    unsigned sum, cnt, mine, sp = 0u;
    for (;;) {
        sum = 0u; cnt = 0u; mine = 0u;
#pragma unroll
        for (unsigned j = 0; j < 16; ++j) { const unsigned c = xb_ld(&bar[XB_XCNT(j)]); sum += c; cnt += (c > 0u) ? 1u : 0u; mine = (j == x) ? c : mine; }
        if (sum == G) break;
        __builtin_amdgcn_s_sleep(1);
        if ((++sp & 255u) == 0u) { if (xb_ld(&bar[XB_TMO])) break; if (sp > XB_SPIN_CAP) { atomicAdd(&bar[XB_TMO], 1u); break; } }
    }
    nloc = mine > 0u ? mine : 1u; nx = cnt > 0u ? cnt : 1u;
}

__device__ __forceinline__ void xcd_barrier(const XcdBarrier& b) {
    asm volatile("s_waitcnt vmcnt(0)" ::: "memory");
    __syncthreads();
    if (threadIdx.x == 0) {
        unsigned* bar = b.bar;
        __builtin_amdgcn_s_waitcnt(0);
        unsigned nloc = b.st[0], nx = b.st[1];
        if (nloc == 0u) { xcd_barrier_complete(bar, b.x, nloc, nx); b.st[0] = nloc; b.st[1] = nx; }
        const unsigned old = xb_add(&bar[XB_XSUB(b.x)], 1u);
        const unsigned gen = old / nloc;
        if (old + 1u == (gen + 1u) * nloc) {
            __builtin_amdgcn_fence(__ATOMIC_RELEASE, "agent");
            asm volatile("s_waitcnt vmcnt(0)" ::: "memory");
            const unsigned og = xb_add(&bar[XB_TOP], 1u);
            const unsigned tg = og / nx;
            if (og + 1u == (tg + 1u) * nx) xb_add(&bar[XB_TOPGEN], 1u);
            else XB_SPIN(xb_ld(&bar[XB_TOPGEN]) == tg, bar);
            __builtin_amdgcn_fence(__ATOMIC_ACQUIRE, "agent");
            xb_add(&bar[XB_XGEN(b.x)], 1u);
            asm volatile("s_waitcnt vmcnt(0)" ::: "memory");
        } else {
            XB_SPIN(xb_ld(&bar[XB_XGEN(b.x)]) == gen, bar);
            __builtin_amdgcn_fence(__ATOMIC_ACQUIRE, "agent");
            asm volatile("s_waitcnt vmcnt(0)" ::: "memory");
        }
    }
    __syncthreads();
}
struct Frame {
    LAS unsigned char* lds;
    volatile LAS unsigned* MISC;
    gu32* ctl;
    int tid, lane, wave, G, bid;
};
template <int CTRL, int ROWMASK = 0xF> __device__ __forceinline__ float dppf(float v) { return __builtin_bit_cast(float, __builtin_amdgcn_update_dpp(0, __builtin_bit_cast(int, v), CTRL, ROWMASK, 0xF, false)); }
__device__ __forceinline__ float wave_sum(float v) {
    v += dppf<0xB1>(v); v += dppf<0x4E>(v); v += dppf<0x141>(v); v += dppf<0x140>(v);
    { const auto r = __builtin_amdgcn_permlane16_swap(__float_as_uint(v), __float_as_uint(v), false, false); v = __uint_as_float(r[0]) + __uint_as_float(r[1]); }
    { const auto r = __builtin_amdgcn_permlane32_swap(__float_as_uint(v), __float_as_uint(v), false, false); v = __uint_as_float(r[0]) + __uint_as_float(r[1]); }
    return v;
}
__device__ __forceinline__ float wave_incl_scan(float x) {
    x += dppf<0x111>(x); x += dppf<0x112>(x); x += dppf<0x114>(x); x += dppf<0x118>(x);
    x += dppf<0x142, 0xA>(x);
    x += dppf<0x143, 0xC>(x);
    return x;
}

__device__ __forceinline__ void transpose_item(const float* src, int src_ld, bf16* dst, int dst_ld, int k0, int ns0, int nd0, LAS float* scr, int lane) {
    f32x4 v[8];
#pragma unroll
    for (int it = 0; it < 8; ++it) { const int kk = (lane >> 3) + 8 * it; v[it] = *(const GAS f32x4*)(src + (size_t)(k0 + kk) * src_ld + ns0 + (lane & 7) * 4); }
#pragma unroll
    for (int it = 0; it < 8; ++it) { const int kk = (lane >> 3) + 8 * it; LAS float* s = scr + kk * 33 + (lane & 7) * 4; s[0] = v[it].x; s[1] = v[it].y; s[2] = v[it].z; s[3] = v[it].w; }
    LDS_WAIT(); asm volatile("" ::: "memory");
    const int c = lane & 7;
#pragma unroll
    for (int j = 0; j < 4; ++j) { const int n = (lane >> 3) + 8 * j; const LAS float* s = scr + (8 * c) * 33 + n;
        v4u o; o.x = pk2(s[0 * 33], s[1 * 33]); o.y = pk2(s[2 * 33], s[3 * 33]); o.z = pk2(s[4 * 33], s[5 * 33]); o.w = pk2(s[6 * 33], s[7 * 33]);
        *(GAS v4u*)(dst + (size_t)(nd0 + n) * dst_ld + k0 + 8 * c) = o; }
    LDS_WAIT(); asm volatile("" ::: "memory");
}
__device__ __forceinline__ void transpose_item8(const float* src, int src_ld, unsigned char* dst, int dst_ld, int k0, int ns0, int nd0, LAS float* scr, int lane, float scale) {
    f32x4 v[16];
#pragma unroll
    for (int it = 0; it < 16; ++it) { const int kk = (lane >> 3) + 8 * it; v[it] = __builtin_nontemporal_load((const GAS f32x4*)(src + (size_t)(k0 + kk) * src_ld + ns0 + (lane & 7) * 4)); }
#pragma unroll
    for (int it = 0; it < 16; ++it) { const int kk = (lane >> 3) + 8 * it; LAS float* s = scr + kk * 33 + ((((lane & 7) + (kk >> 4)) * 4) & 31);
        s[0] = v[it].x * scale; s[1] = v[it].y * scale; s[2] = v[it].z * scale; s[3] = v[it].w * scale; }
    LDS_WAIT(); asm volatile("" ::: "memory");
    const int c = lane & 7;
#pragma unroll
    for (int j = 0; j < 4; ++j) { const int n = (lane >> 3) + 8 * j; const LAS float* s = scr + (16 * c) * 33 + ((n + 4 * c) & 31);
        v4u o; o.x = pg8::pk4_fp8(s[0 * 33], s[1 * 33], s[2 * 33], s[3 * 33]); o.y = pg8::pk4_fp8(s[4 * 33], s[5 * 33], s[6 * 33], s[7 * 33]);
        o.z = pg8::pk4_fp8(s[8 * 33], s[9 * 33], s[10 * 33], s[11 * 33]); o.w = pg8::pk4_fp8(s[12 * 33], s[13 * 33], s[14 * 33], s[15 * 33]);
        *(GAS v4u*)(dst + (size_t)(nd0 + n) * dst_ld + k0 + 16 * c) = o; }
    LDS_WAIT(); asm volatile("" ::: "memory");
}
struct ProIn { const float *c, *gmix, *gffn, *ada_w, *ada_b, *pool_w, *pool_scale, *fox_w_in, *fox_w_o, *exp_w_in, *exp_w_out; };
__device__ __forceinline__ void p0_prologue(Frame& F0, const ProIn& P, unsigned char* ws) {
    Frame F = F0; { int t_ = F0.tid; asm volatile("" : "+v"(t_)); F.tid = t_; F.lane = t_ & 63; F.wave = __builtin_amdgcn_readfirstlane(t_ >> 6); }
    LAS float* sc = (LAS float*)(F.lds + RING_OFF);
    LAS float* red = (LAS float*)(F.lds + RING_OFF + 16384);
    for (int i = F.tid; i < BATCH * D; i += NWAVES * 64) { const float v = P.c[i]; sc[i] = v / (1.0f + __expf(-v)); }
    __syncthreads();
    float* MODV = (float*)(ws + WS_MODV);
    for (int it = F.bid; it < DEPTH * 48; it += F.G) {
        const int L = it / 48, n0 = (it % 48) * 128;
        const float* wp = P.ada_w + ((size_t)L * D + 128 * F.wave) * (6 * D) + n0 + 2 * F.lane;
        float a00 = 0.f, a01 = 0.f, a10 = 0.f, a11 = 0.f, a20 = 0.f, a21 = 0.f, a30 = 0.f, a31 = 0.f;
#pragma unroll 16
        for (int k = 0; k < 128; ++k) { const pg8::f32x2 wv = *(const GAS pg8::f32x2*)(wp + (size_t)k * (6 * D)); const int kk = 128 * F.wave + k;
            const float s0 = sc[kk], s1 = sc[D + kk], s2 = sc[2 * D + kk], s3 = sc[3 * D + kk];
            a00 += s0 * wv.x; a01 += s0 * wv.y; a10 += s1 * wv.x; a11 += s1 * wv.y; a20 += s2 * wv.x; a21 += s2 * wv.y; a30 += s3 * wv.x; a31 += s3 * wv.y; }
        { LAS pg8::f32x2* rp = (LAS pg8::f32x2*)(red + (F.wave * 4) * 128) + F.lane;
          rp[0] = (pg8::f32x2){a00, a01}; rp[64] = (pg8::f32x2){a10, a11}; rp[128] = (pg8::f32x2){a20, a21}; rp[192] = (pg8::f32x2){a30, a31}; }
        __syncthreads();
        { const int b = F.tid >> 7, ln = F.tid & 127, nn = n0 + ln; float m = P.ada_b[L * 6 * D + nn];
#pragma unroll
            for (int w = 0; w < 8; ++w) m += red[(w * 4 + b) * 128 + ln];
            const int j = nn >> 10, cc = nn & 1023;
            if (j == 1) m = P.gmix[L * D + cc] * (1.0f + m);
            else if (j == 2) { if (!(L & 1)) m *= P.pool_scale[(L >> 1) * D + cc]; }
            else if (j == 4) m = P.gffn[L * D + cc] * (1.0f + m);
            MODV[((size_t)(L * BATCH + b) * 6 + j) * D + cc] = m; }
        __syncthreads();
    }
    LAS float* scr = (LAS float*)(F.lds + RING_OFF + F.wave * 16896);
    const int gw = F.bid * NWAVES + F.wave, NGW = F.G * NWAVES;
    static_assert(8 * 16896 <= MISC_OFF, "prologue scratch vs LDS map");
    constexpr int I_W1 = DEPTH * NEXP * 512, I_W2 = DEPTH * NEXP * 256, I_QKV = 2 * 768, I_WO = 2 * 256, I_PL = 8 * 32;
    for (int it = gw; it < I_W1 + I_W2 + I_QKV + I_WO + I_PL; it += NGW) {
        int r = it;
        if (r < I_W1) { const int m = r >> 9, q = r & 511, kb = q >> 6, nb = q & 63, nd0 = 32 * nb, pn = nd0 >> 8, j = nd0 & 255;
            const int ns0 = (j < 128) ? (128 * pn + j) : (FF + 128 * pn + (j - 128));
            transpose_item8(P.exp_w_in + (size_t)m * D * 2 * FF, 2 * FF, (unsigned char*)(ws + WS_W1) + (size_t)m * 2 * FF * D, D, 128 * kb, ns0, nd0, scr, F.lane, pg8::FP8_SW); continue; }
        r -= I_W1;
        if (r < I_W2) { const int m = r >> 8, q = r & 255, kb = q >> 5, nb = q & 31;
            transpose_item8(P.exp_w_out + (size_t)m * FF * D, D, (unsigned char*)(ws + WS_W2) + (size_t)m * D * FF, FF, 128 * kb, 32 * nb, 32 * nb, scr, F.lane, pg8::FP8_SW); continue; }
        r -= I_W2;
        if (r < I_QKV) { const int m = r / 768, q = r % 768, kb = q / 96, nb = q % 96;
            transpose_item8(P.fox_w_in + (size_t)m * D * FOX_LD, FOX_LD, (unsigned char*)(ws + WS_WQKV) + (size_t)m * NQKV * D, D, 128 * kb, 32 * nb, 32 * nb, scr, F.lane, pg8::FP8_SW); continue; }
        r -= I_QKV;
        if (r < I_WO) { const int m = r >> 8, q = r & 255, kb = q >> 5, nb = q & 31;
            transpose_item8(P.fox_w_o + (size_t)m * D * D, D, (unsigned char*)(ws + WS_WO) + (size_t)m * D * D, D, 128 * kb, 32 * nb, 32 * nb, scr, F.lane, pg8::FP8_SW); continue; }
        r -= I_WO;
        { const int m = r >> 5, q = r & 31, kb = q >> 3, nb = q & 7;
            transpose_item(P.pool_w + (size_t)m * 65536, 256, (bf16*)(ws + WS_WPOOL) + (size_t)m * 65536, 256, 64 * kb, 32 * nb, 32 * nb, scr, F.lane); }
    }
}

__device__ __forceinline__ f32x4 fp8x4_f32(unsigned w) { typedef float f2 __attribute__((ext_vector_type(2))); const f2 lo = __builtin_amdgcn_cvt_pk_f32_fp8((int)w, false), hi = __builtin_amdgcn_cvt_pk_f32_fp8((int)w, true); return (f32x4){lo.x, lo.y, hi.x, hi.y}; }
__device__ __forceinline__ f32x4 ys_sum4(unsigned a, unsigned b, unsigned c, unsigned d) { return (fp8x4_f32(a) + fp8x4_f32(b)) + (fp8x4_f32(c) + fp8x4_f32(d)); }
template <bool BF> struct XRaw { typedef f32x4 T; };
template <> struct XRaw<true> { typedef v2u T; };
template <bool BF> __device__ __forceinline__ typename XRaw<BF>::T ldxraw(const void* base, size_t eoff) {
    if constexpr (BF) return *(const GAS v2u*)((const bf16*)base + eoff); else return *(const GAS f32x4*)((const float*)base + eoff);
}
__device__ __forceinline__ f32x4 xraw_f32(v2u w) { return (f32x4){bflo(w.x), bfhi(w.x), bflo(w.y), bfhi(w.y)}; }
__device__ __forceinline__ f32x4 xraw_f32(f32x4 w) { return w; }
template <int MODE, bool SRCBF>
__device__ __forceinline__ void rows_phase(Frame& F0, bool combine, const void* xsrc, void* xdst, const unsigned char* ys, const float* g2v, float* r1out, const float* fg) {
    Frame F = F0; { int t_ = F0.tid; asm volatile("" : "+v"(t_)); F.tid = t_; F.lane = t_ & 63; F.wave = __builtin_amdgcn_readfirstlane(t_ >> 6); }
    typedef typename XRaw<SRCBF>::T XT;
    const int gw = F.bid * NWAVES + F.wave, NGW = F.G * NWAVES, per = (T + NGW - 1) / NGW, r0 = gw * per, r1 = (r0 + per < T) ? r0 + per : T;
    if (r0 >= r1) return;
    XT xn[4]; unsigned yn[4][4];
#define RP_LOAD(rw) do { _Pragma("unroll") for (int j_ = 0; j_ < 4; ++j_) xn[j_] = ldxraw<SRCBF>(xsrc, (size_t)(rw) * D + 4 * F.lane + 256 * j_); \
        if (combine) { _Pragma("unroll") for (int k_ = 0; k_ < 4; ++k_) { _Pragma("unroll") for (int j_ = 0; j_ < 4; ++j_) yn[k_][j_] = *((const GAS unsigned*)(ys + ((size_t)(rw) * 4 + k_) * D) + F.lane + 64 * j_); } } } while (0)
    RP_LOAD(r0);
    f32x4 fgv[4], g2r[4]; int bcur = -1;
    if (MODE == 1) {
#pragma unroll
        for (int j = 0; j < 4; ++j) fgv[j] = *((const GAS f32x4*)fg + F.lane + 64 * j); }
#pragma unroll 1
    for (int row = r0; row < r1; ++row) {
        const int b = row >> 13;
        XT xc[4]; unsigned yc[4][4];
#pragma unroll
        for (int j = 0; j < 4; ++j) { xc[j] = xn[j];
#pragma unroll
            for (int k = 0; k < 4; ++k) yc[k][j] = yn[k][j]; }
        if (combine && b != bcur) {
#pragma unroll
            for (int j = 0; j < 4; ++j) g2r[j] = *((const GAS f32x4*)(g2v + (size_t)b * 6 * D) + F.lane + 64 * j) * (1.0f / pg8::YS_SCALE);
            bcur = b; }
        if (row + 1 < r1) RP_LOAD(row + 1);
        f32x4 v[4];
#pragma unroll
        for (int j = 0; j < 4; ++j) v[j] = xraw_f32(xc[j]);
        if (combine) {
#pragma unroll
            for (int j = 0; j < 4; ++j) v[j] = v[j] + g2r[j] * ys_sum4(yc[0][j], yc[1][j], yc[2][j], yc[3][j]);
        }
        float ss = 0.f;
#pragma unroll
        for (int j = 0; j < 4; ++j) ss += (v[j].x * v[j].x + v[j].y * v[j].y) + (v[j].z * v[j].z + v[j].w * v[j].w);
        const float r = 1.0f / sqrtf(wave_sum(ss) * (1.0f / D) + EPS);
        if (MODE == 0) {
            if (combine) {
#pragma unroll
                for (int j = 0; j < 4; ++j) stx4_bf((bf16*)xdst, (size_t)row * D + 4 * F.lane + 256 * j, v[j]); }
            if (F.lane == 0) r1out[row] = r;
        } else {
            GAS f32x4* xo = (GAS f32x4*)((float*)xdst + (size_t)row * D) + F.lane;
#pragma unroll
            for (int j = 0; j < 4; ++j) xo[64 * j] = v[j] * r * fgv[j];
        }
    }
#undef RP_LOAD
}

template <bool SRCBF>
__device__ __forceinline__ void pool_d_phase(Frame& F0, const void* xsrc, const float* r1, const float* G1v, bf16* dout) {
    Frame F = F0; { int t_ = F0.tid; asm volatile("" : "+v"(t_)); F.tid = t_; F.lane = t_ & 63; F.wave = __builtin_amdgcn_readfirstlane(t_ >> 6); }
    typedef typename XRaw<SRCBF>::T XT;
    const int half = F.tid >> 8, cq = F.tid & 255, c0 = 4 * cq, w = __builtin_amdgcn_readfirstlane(2 << (cq >> 6));
    LAS f32x4* ring = (LAS f32x4*)(F.lds + RING_OFF) + F.tid;
    static_assert(16 * NWAVES * 64 * 16 <= RING_BYTES, "pool ring");
    for (int tile = F.bid; tile < T / 64; tile += F.G) {
        const int t0 = tile * 64 + 32 * half, b = t0 >> 13, tl0 = t0 & (SEQ - 1);
        const f32x4 Gc = *(const GAS f32x4*)(G1v + (size_t)b * 6 * D + c0);
        const size_t xb = (size_t)t0 * D + c0;
        const int kfirst = (-(w - 1) > -tl0) ? -(w - 1) : -tl0;
        f32x4 s = pg8::zero4();
        XT XA[8], XB[8]; float RA[8], RB[8];
#define PD_LOAD(XQ, RQ, kc) do { if ((kc) + 7 >= kfirst) { _Pragma("unroll") for (int j_ = 0; j_ < 8; ++j_) { const int k_ = (kc) + j_; if (k_ >= kfirst) { \
            XQ[j_] = ldxraw<SRCBF>(xsrc, (size_t)((long)xb + (long)k_ * D)); RQ[j_] = r1[t0 + k_]; } } } } while (0)
#define PD_PROC(XQ, RQ, kc) do { if ((kc) + 7 >= kfirst) { _Pragma("unroll") for (int j_ = 0; j_ < 8; ++j_) { const int k_ = (kc) + j_; if (k_ >= kfirst) { \
            const f32x4 v = xraw_f32(XQ[j_]) * RQ[j_]; s = s + v; ring[(k_ & 15) * (NWAVES * 64)] = v; \
            if (k_ >= 0) { const int tl = tl0 + k_; const float inv = 1.0f / (float)((tl + 1 < w) ? (tl + 1) : w); \
                const f32x4 d = Gc * (s * inv - v); v2u o; o.x = pk2(d.x, d.y); o.y = pk2(d.z, d.w); \
                *(GAS v2u*)(dout + (size_t)(t0 + k_) * D + c0) = o; \
                if (tl - (w - 1) >= 0) s = s - ring[((k_ - (w - 1)) & 15) * (NWAVES * 64)]; } } } } } while (0)
        PD_LOAD(XA, RA, -16); PD_LOAD(XB, RB, -8);
        PD_PROC(XA, RA, -16); PD_LOAD(XA, RA, 0);
        PD_PROC(XB, RB, -8);  PD_LOAD(XB, RB, 8);
        PD_PROC(XA, RA, 0);   PD_LOAD(XA, RA, 16);
        PD_PROC(XB, RB, 8);   PD_LOAD(XB, RB, 24);
        PD_PROC(XA, RA, 16);
        PD_PROC(XB, RB, 24);
#undef PD_LOAD
#undef PD_PROC
    }
}

constexpr int NP_TROW = 1032;
constexpr int NP_TILE = 0, NP_TLO = 16 * NP_TROW * 2, NP_PART = 66048, NP_LOGI = NP_PART + 16384, NP_PE = NP_LOGI + 2048, NP_PPOS = NP_PE + 4096, NP_PG = NP_PPOS + 4096, NP_PPAIR = NP_PG + 4096, NP_LCNT = NP_PPAIR + 4096, NP_BASE = NP_LCNT + 128, NP_TOPV = NP_BASE + 128, NP_MOD = NP_TOPV + 256, NP_END = NP_MOD + 3 * 4096;
static_assert(NP_END <= RING_BYTES && NP_MOD % 16 == 0, "norm phase LDS");
#define LDS_BARRIER() do { asm volatile("s_waitcnt lgkmcnt(0)" ::: "memory"); __builtin_amdgcn_s_barrier(); asm volatile("" ::: "memory"); } while (0)
template <bool FOX>
__device__ __forceinline__ void norm_proj_phase(Frame& F0, const bf16* xsrc, bf16* xdst, const unsigned char* ys, const float* g2v, const float* Gv, const float* Sv,
                                                const float* W, int w_ld, const float* bias, bf16* hout, float* LF, unsigned* gcnt, int* slot_pair, float* slot_gate, bool dry = false) {
    constexpr int NEC = FOX ? 16 : 32, NEH = NEC / 16, NYK = FOX ? 4 : 1;
    Frame F = F0; { int t_ = F0.tid; asm volatile("" : "+v"(t_)); F.tid = t_; F.lane = t_ & 63; F.wave = __builtin_amdgcn_readfirstlane(t_ >> 6); }
    LAS unsigned short* THI = (LAS unsigned short*)(F.lds + NP_TILE); LAS unsigned short* TLO = (LAS unsigned short*)(F.lds + NP_TLO); LAS float* PART = (LAS float*)(F.lds + NP_PART); LAS float* LOGI = (LAS float*)(F.lds + NP_LOGI);
    LAS int* P_E = (LAS int*)(F.lds + NP_PE); LAS int* P_POS = (LAS int*)(F.lds + NP_PPOS); LAS float* P_G = (LAS float*)(F.lds + NP_PG); LAS int* P_PAIR = (LAS int*)(F.lds + NP_PPAIR);
    LAS int* LCNT = (LAS int*)(F.lds + NP_LCNT); LAS int* BASE = (LAS int*)(F.lds + NP_BASE); LAS float* TOPV = (LAS float*)(F.lds + NP_TOPV); LAS float* MOD = (LAS float*)(F.lds + NP_MOD);
    const int lane = F.lane, w = F.wave, r = lane & 15, q = lane >> 4;
    const int NT = T / 16, per = (NT + F.G - 1) / F.G, tl0 = F.bid * per, tl1 = (tl0 + per < NT) ? tl0 + per : NT;
    v2u xn[2][4]; unsigned yn[2][NYK][4];
#define NP_LOADX(tlx) do { _Pragma("unroll") for (int rr_ = 0; rr_ < 2; ++rr_) { const int tk_ = (tlx) * 16 + 2 * w + rr_; const GAS v2u* xr_ = (const GAS v2u*)(xsrc + (size_t)tk_ * D) + lane; \
        _Pragma("unroll") for (int j_ = 0; j_ < 4; ++j_) xn[rr_][j_] = xr_[64 * j_]; \
        if (FOX) { _Pragma("unroll") for (int k_ = 0; k_ < NYK; ++k_) { _Pragma("unroll") for (int j_ = 0; j_ < 4; ++j_) yn[rr_][k_][j_] = *((const GAS unsigned*)(ys + ((size_t)tk_ * 4 + k_) * D) + lane + 64 * j_); } } } } while (0)
    if (tl0 < tl1) NP_LOADX(tl0);
    const float bias_e = (F.tid < 16 * NEC) ? bias[F.tid % NEC] : 0.f;
    typedef short bf16x8v __attribute__((ext_vector_type(8)));
    v4u whi[4][NEH], wlo[4][NEH];
#pragma unroll
    for (int s = 0; s < 4; ++s)
#pragma unroll
        for (int eh = 0; eh < NEH; ++eh) { float wv[8];
#pragma unroll
            for (int j = 0; j < 8; ++j) wv[j] = W[(size_t)(128 * w + 32 * s + 8 * q + j) * w_ld + 16 * eh + r];
#pragma unroll
            for (int p = 0; p < 4; ++p) { const unsigned hb = pk2(wv[2 * p], wv[2 * p + 1]); whi[s][eh][p] = hb; wlo[s][eh][p] = pk2(wv[2 * p] - bflo(hb), wv[2 * p + 1] - bfhi(hb)); } }
    if (!FOX) { if (F.tid < 32) LCNT[F.tid] = 0; }
    int bcur = -1;
    int nloc = 0;
    for (int tl = tl0; tl < tl1; ++tl, ++nloc) {
        const int b = tl >> 9;
        if (b != bcur) {
            for (int i = F.tid; i < 768; i += NWAVES * 64) { const int vec = i >> 8, c4 = i & 255;
                if (FOX || vec > 0) { const float* src = (vec == 0) ? g2v : (vec == 1) ? Gv : Sv; f32x4 val = *((const GAS f32x4*)(src + (size_t)b * 6 * D) + c4);
                    if (vec == 0) val = val * (1.0f / pg8::YS_SCALE);
                    *(LAS f32x4*)(MOD + vec * 1024 + 4 * c4) = val; } }
            bcur = b;
            LDS_BARRIER();
        }
        v2u xc[2][4]; unsigned yc[2][NYK][4];
#pragma unroll
        for (int rr = 0; rr < 2; ++rr) {
#pragma unroll
            for (int j = 0; j < 4; ++j) xc[rr][j] = xn[rr][j];
            if (FOX) {
#pragma unroll
                for (int k = 0; k < NYK; ++k)
#pragma unroll
                    for (int j = 0; j < 4; ++j) yc[rr][k][j] = yn[rr][k][j]; } }
        if (tl + 1 < tl1) NP_LOADX(tl + 1);
#pragma unroll
        for (int rr = 0; rr < 2; ++rr) {
            const int row = 2 * w + rr, tok = tl * 16 + row;
            f32x4 v[4];
#pragma unroll
            for (int j = 0; j < 4; ++j) v[j] = (f32x4){bflo(xc[rr][j].x), bfhi(xc[rr][j].x), bflo(xc[rr][j].y), bfhi(xc[rr][j].y)};
            if (FOX) {
#pragma unroll
                for (int j = 0; j < 4; ++j) { const f32x4 g = *(const LAS f32x4*)(MOD + 4 * lane + 256 * j);
                    v[j] = v[j] + g * ys_sum4(yc[rr][0][j], yc[rr][NYK > 1 ? 1 : 0][j], yc[rr][NYK > 2 ? 2 : 0][j], yc[rr][NYK > 3 ? 3 : 0][j]); }
#pragma unroll
                for (int j = 0; j < 4; ++j) stx4_bf(xdst, (size_t)tok * D + 4 * lane + 256 * j, v[j]);
            }
            float ss = 0.f;
#pragma unroll
            for (int j = 0; j < 4; ++j) ss += (v[j].x * v[j].x + v[j].y * v[j].y) + (v[j].z * v[j].z + v[j].w * v[j].w);
            const float rinv = 1.0f / sqrtf(wave_sum(ss) * (1.0f / D) + EPS);
#pragma unroll
            for (int j = 0; j < 4; ++j) {
                const f32x4 g = *(const LAS f32x4*)(MOD + 1024 + 4 * lane + 256 * j), sh = *(const LAS f32x4*)(MOD + 2048 + 4 * lane + 256 * j);
                const f32x4 h = v[j] * rinv * g + sh;
                *((GAS unsigned*)((unsigned char*)hout + (size_t)tok * D) + lane + 64 * j) = pg8::pk4_fp8(h.x * pg8::FP8_SA, h.y * pg8::FP8_SA, h.z * pg8::FP8_SA, h.w * pg8::FP8_SA);
                { v2u hh; hh.x = pk2(h.x, h.y); hh.y = pk2(h.z, h.w); v2u hl; hl.x = pk2(h.x - bflo(hh.x), h.y - bfhi(hh.x)); hl.y = pk2(h.z - bflo(hh.y), h.w - bfhi(hh.y));
                  *(LAS v2u*)(THI + row * NP_TROW + 256 * j + 4 * lane) = hh; *(LAS v2u*)(TLO + row * NP_TROW + 256 * j + 4 * lane) = hl; }
            }
        }
        LDS_BARRIER();
        {
            f32x4 acc[NEH];
#pragma unroll
            for (int eh = 0; eh < NEH; ++eh) acc[eh] = pg8::zero4();
#pragma unroll
            for (int s = 0; s < 4; ++s) { const v4u ah = *(const LAS v4u*)(THI + r * NP_TROW + 128 * w + 32 * s + 8 * q), al = *(const LAS v4u*)(TLO + r * NP_TROW + 128 * w + 32 * s + 8 * q);
#pragma unroll
                for (int eh = 0; eh < NEH; ++eh) {
                    acc[eh] = __builtin_amdgcn_mfma_f32_16x16x32_bf16(__builtin_bit_cast(bf16x8v, ah), __builtin_bit_cast(bf16x8v, whi[s][eh]), acc[eh], 0, 0, 0);
                    acc[eh] = __builtin_amdgcn_mfma_f32_16x16x32_bf16(__builtin_bit_cast(bf16x8v, al), __builtin_bit_cast(bf16x8v, whi[s][eh]), acc[eh], 0, 0, 0);
                    acc[eh] = __builtin_amdgcn_mfma_f32_16x16x32_bf16(__builtin_bit_cast(bf16x8v, ah), __builtin_bit_cast(bf16x8v, wlo[s][eh]), acc[eh], 0, 0, 0); } }
#pragma unroll
            for (int eh = 0; eh < NEH; ++eh)
#pragma unroll
                for (int i = 0; i < 4; ++i) PART[(w * 16 + 4 * q + i) * 32 + 16 * eh + r] = acc[eh][i];
        }
        LDS_BARRIER();
        float logit_own = bias_e;
        if (F.tid < 16 * NEC) { const int token = F.tid / NEC, e = F.tid % NEC;
#pragma unroll
            for (int ww = 0; ww < 8; ++ww) logit_own += PART[(ww * 16 + token) * 32 + e];
            if (!FOX) LOGI[token * 32 + e] = logit_own; }
        LDS_WAIT(); asm volatile("" ::: "memory");
        if (FOX) {
            if (F.tid < 256) { const int token = F.tid >> 4, hh = F.tid & 15; const float z = logit_own;
                const float lf = fminf(z, 0.f) - 0.69314718056f * __builtin_amdgcn_logf(1.0f + __builtin_amdgcn_exp2f(-1.4426950408889634f * fabsf(z)));
                const int tg = tl * 16 + token; LF[((size_t)(tg >> 13) * NH + hh) * SEQ + (tg & (SEQ - 1))] = lf; }
        } else if (nloc < 16) {
            const int token = F.tid >> 5, e = F.tid & 31; const LAS float* lg = LOGI + token * 32; const float v = lg[e]; int rank = 0;
#pragma unroll
            for (int e2 = 0; e2 < 32; ++e2) { const float o = lg[e2]; rank += (o > v || (o == v && e2 < e)) ? 1 : 0; }
            if (rank < 4) TOPV[token * 4 + rank] = v;
            LDS_WAIT(); asm volatile("" ::: "memory");
            if (rank < 4) { const float t0 = TOPV[token * 4], e0 = __expf(TOPV[token * 4 + 1] - t0), e1 = __expf(TOPV[token * 4 + 2] - t0), e2x = __expf(TOPV[token * 4 + 3] - t0);
                const float gate = __expf(v - t0) / (1.0f + e0 + e1 + e2x);
                const int pl = nloc * 64 + token * 4 + rank;
                const int lp = __hip_atomic_fetch_add((int*)(LCNT + e), 1, __ATOMIC_RELAXED, __HIP_MEMORY_SCOPE_WORKGROUP);
                P_E[pl] = e; P_POS[pl] = lp; P_G[pl] = gate; P_PAIR[pl] = (tl * 16 + token) * 4 + rank; }
        }
    }
#undef NP_LOADX
    if (!FOX) {
        __syncthreads();
        if (F.tid < 32) BASE[F.tid] = dry ? 0 : (int)__hip_atomic_fetch_add(gcnt + F.tid, (unsigned)LCNT[F.tid], RLX_AGENT);
        __syncthreads();
        const int np = dry ? 0 : (nloc < 16 ? nloc : 16) * 64;
        for (int pl = F.tid; pl < np; pl += NWAVES * 64) { const int e = P_E[pl]; const size_t slot = (size_t)e * T + BASE[e] + P_POS[pl];
            slot_pair[slot] = P_PAIR[pl]; slot_gate[slot] = P_G[pl]; }
    }
    __syncthreads();
}

__device__ __forceinline__ void fox_scan(Frame& F0, const float* LF, float* FB) {
    Frame F = F0; { int t_ = F0.tid; asm volatile("" : "+v"(t_)); F.tid = t_; F.lane = t_ & 63; F.wave = __builtin_amdgcn_readfirstlane(t_ >> 6); }
    LAS float* wt = (LAS float*)(F.lds + RING_OFF);
    for (int seq = F.bid; seq < BATCH * NH; seq += F.G) {
        const GAS f32x4* src = (const GAS f32x4*)(LF + (size_t)seq * SEQ + 16 * F.tid);
        f32x4 v[4];
#pragma unroll
        for (int j = 0; j < 4; ++j) v[j] = src[j];
        float c[16]; float run = 0.f;
#pragma unroll
        for (int j = 0; j < 4; ++j) { run += v[j].x; c[4 * j] = run; run += v[j].y; c[4 * j + 1] = run; run += v[j].z; c[4 * j + 2] = run; run += v[j].w; c[4 * j + 3] = run; }
        const float incl = wave_incl_scan(run);
        if (F.lane == 63) wt[F.wave] = incl;
        __syncthreads();
        float off = incl - run;
        for (int ww = 0; ww < F.wave; ++ww) off += wt[ww];
        GAS f32x4* dst = (GAS f32x4*)(FB + (size_t)seq * SEQ + 16 * F.tid);
#pragma unroll
        for (int j = 0; j < 4; ++j) dst[j] = (f32x4){(off + c[4 * j]) * -1.4426950408889634f, (off + c[4 * j + 1]) * -1.4426950408889634f, (off + c[4 * j + 2]) * -1.4426950408889634f, (off + c[4 * j + 3]) * -1.4426950408889634f};
        __syncthreads();
    }
}

constexpr int UL_OFF = SCHED_OFF + 320, UL_MAX = 24;
__device__ __forceinline__ void moe_setup(Frame& F0, const unsigned* gcnt, int nN, bool reuse = false) {
    Frame F = F0; { int t_ = F0.tid; asm volatile("" : "+v"(t_)); F.tid = t_; F.lane = t_ & 63; F.wave = __builtin_amdgcn_readfirstlane(t_ >> 6); }
    LAS int* CNT = (LAS int*)(F.lds + SCHED_OFF); LAS int* TPRE = CNT + 32; LAS int* UL = (LAS int*)(F.lds + UL_OFF);
    __syncthreads();
    if (!reuse) {
        if (F.tid < 32) { const unsigned c = __hip_atomic_load(gcnt + F.tid, RLX_AGENT); CNT[F.tid] = (int)(c < (unsigned)T ? c : (unsigned)T); }
        __syncthreads();
        if (F.tid == 0) { int a = 0; for (int e = 0; e < 32; ++e) { TPRE[e] = a; a += (CNT[e] + 255) >> 8; } TPRE[32] = a < MAXMT ? a : MAXMT; }
        __syncthreads();
    }
    if (F.tid < UL_MAX) { const int MT = TPRE[32]; int pm = -1, pn = 0, e = 0;
        if (F.tid < UL_MAX - 1 && pg8::tile_order(F.tid, F.G, F.bid, MT, nN, pm, pn)) { for (int k = 0; k < 31; ++k) if (TPRE[k + 1] <= pm) e = k + 1; } else pm = -1;
        LAS int* p = UL + 5 * F.tid; p[0] = pm; p[1] = pn; p[2] = e; p[3] = CNT[e]; p[4] = pm - TPRE[e]; }
    __syncthreads();
}
__device__ __forceinline__ void qk_stats_phase(Frame& F0, const bf16* Q, const bf16* K, unsigned* QN2, unsigned* KN2) {
    Frame F = F0; { int t_ = F0.tid; asm volatile("" : "+v"(t_)); F.tid = t_; F.lane = t_ & 63; F.wave = __builtin_amdgcn_readfirstlane(t_ >> 6); }
    const int gw = F.bid * NWAVES + F.wave, NGW = F.G * NWAVES;
    for (int it = gw; it < T / 16; it += NGW) {
        const int t0 = it * 16; float qm = 0.f, km = 0.f;
#pragma unroll 4
        for (int i = 0; i < 16; ++i) {
            const GAS v4u* qp = (const GAS v4u*)(Q + (size_t)(t0 + i) * D + 16 * F.lane); const GAS v4u* kp = (const GAS v4u*)(K + (size_t)(t0 + i) * D + 16 * F.lane);
            const v4u qa = qp[0], qb = qp[1], ka = kp[0], kb = kp[1];
            float qs = 0.f, ks = 0.f;
#pragma unroll
            for (int e = 0; e < 4; ++e) { qs += bflo(qa[e]) * bflo(qa[e]) + bfhi(qa[e]) * bfhi(qa[e]) + bflo(qb[e]) * bflo(qb[e]) + bfhi(qb[e]) * bfhi(qb[e]);
                                          ks += bflo(ka[e]) * bflo(ka[e]) + bfhi(ka[e]) * bfhi(ka[e]) + bflo(kb[e]) * bflo(kb[e]) + bfhi(kb[e]) * bfhi(kb[e]); }
            qs += dppf<0xB1>(qs); qs += dppf<0x4E>(qs); ks += dppf<0xB1>(ks); ks += dppf<0x4E>(ks);
            qm = fmaxf(qm, qs); km = fmaxf(km, ks);
        }
        if ((F.lane & 3) == 0) { const int b = t0 >> 13, h = F.lane >> 2, qb = (t0 & (SEQ - 1)) >> 8;
            __hip_atomic_fetch_max(QN2 + (b * NH + h) * 32 + qb, __float_as_uint(qm), RLX_AGENT); __hip_atomic_fetch_max(KN2 + b * NH + h, __float_as_uint(km), RLX_AGENT); }
    }
}
constexpr int PH_FINAL = 1 + 8 * DEPTH, NPH = PH_FINAL + 1;
struct Args { const float* in[18]; float* out; unsigned char* ws; int ph_lo, ph_hi; };
#define KARG() ({ const __attribute__((address_space(4))) Args* p_ = (const __attribute__((address_space(4))) Args*)__builtin_amdgcn_kernarg_segment_ptr(); asm volatile("" : "+s"(p_)); p_; })
#define MKFRAME(F, ws) Frame F; F.lds = (LAS unsigned char*)lds; F.MISC = (volatile LAS unsigned*)(F.lds + MISC_OFF); F.tid = threadIdx.x; F.lane = F.tid & 63; F.wave = __builtin_amdgcn_readfirstlane(F.tid >> 6); { int g_ = gridDim.x, b_ = blockIdx.x; asm volatile("" : "+s"(g_), "+s"(b_)); F.G = g_; F.bid = b_; } F.ctl = (gu32*)((ws) + WS_CTL)
__global__ void __launch_bounds__(NWAVES * 64, 2) enc_fwd(Args args) {
    extern __shared__ __attribute__((aligned(16))) unsigned char lds[];
    {
        for (int u = threadIdx.x; u < (LDS_BYTES - IDX_OFF) / 4; u += NWAVES * 64) ((LAS unsigned*)((LAS unsigned char*)lds + IDX_OFF))[u] = 0u;
        __syncthreads();
        if (MK_N_LAUNCHES == 1) { const auto* ap = KARG(); (void)xcd_barrier_post((unsigned*)((gu32*)(ap->ws + WS_CTL) + CW_BAR), (volatile LAS unsigned*)((LAS unsigned char*)lds + MISC_OFF) + 8); }
    }
#define SEAM() do { if (MK_N_LAUNCHES == 1) { const auto* ap_ = KARG(); XcdBarrier bar_; bar_.bar = (unsigned*)((gu32*)(ap_->ws + WS_CTL) + CW_BAR); bar_.x = xb_xcc_id(); bar_.st = (volatile LAS unsigned*)((LAS unsigned char*)lds + MISC_OFF) + 8; xcd_barrier(bar_); } } while (0)
    const int lo = args.ph_lo, hi = args.ph_hi;
#ifndef DBG_MASK
#define DBG_MASK 0xFFFF
#endif
#define EN(b) ((DBG_MASK >> (b)) & 1)
#ifndef DBG_DUP
#define DBG_DUP 0
#endif
#define REPS(b) for (int rep_ = 0; rep_ < (((DBG_DUP >> (b)) & 1) ? 2 : 1); ++rep_)
#define IN(k) (lo <= (k) && (k) < hi)
#define P_MODV(ws) ((float*)((ws) + WS_MODV))
#define P_HB(ws) ((bf16*)((ws) + WS_HB))
#define P_YS(ws) ((unsigned char*)((ws) + WS_YS))

    if (EN(0) && IN(0)) {
        REPS(0) { const auto* ap = KARG(); unsigned char* ws = ap->ws; MKFRAME(F, ws);
            ProIn P{ap->in[1], ap->in[2], ap->in[3], ap->in[4], ap->in[5], ap->in[6], ap->in[7], ap->in[8], ap->in[10], ap->in[13], ap->in[15]};
            p0_prologue(F, P, ws);
            if (MK_NBRANCH > 0) rows_phase<0, false>(F, false, ap->in[0], nullptr, P_YS(ws), P_MODV(ws), (float*)(ws + WS_R1), nullptr);
            SEAM(); }
    }
#pragma unroll 1
    for (int L = 0; L < DEPTH; ++L) {
        const int ph = 1 + 8 * L, jx = L >> 1;
        const bool odd = (L & 1) != 0, do_mix = (2 * L < MK_NBRANCH), do_moe = (2 * L + 1 < MK_NBRANCH);
#define P_XB(ws) ((bf16*)((ws) + WS_XB))
#define MV(ws) (P_MODV(ws) + (size_t)L * BATCH * 6 * D)
#define MVP(ws) (P_MODV(ws) + (size_t)(L > 0 ? L - 1 : 0) * BATCH * 6 * D)
        if (do_mix) {
            if (!odd) {
                if (EN(1) && IN(ph + 0) && L > 0) REPS(1) { const auto* ap = KARG(); unsigned char* ws = ap->ws; MKFRAME(F, ws); const bool dry = (rep_ == 0) && ((DBG_DUP >> 1) & 1);
                    rows_phase<0, true>(F, true, P_XB(ws), dry ? (void*)(ws + WS_ACT) : (void*)P_XB(ws), P_YS(ws), MVP(ws) + 5 * D, (float*)(ws + WS_R1), nullptr); SEAM(); }
                if (EN(2) && IN(ph + 1)) REPS(2) { const auto* ap = KARG(); unsigned char* ws = ap->ws; MKFRAME(F, ws);
                    if (L == 0) pool_d_phase<false>(F, ap->in[0], (const float*)(ws + WS_R1), MV(ws) + 1 * D, P_HB(ws)); else pool_d_phase<true>(F, P_XB(ws), (const float*)(ws + WS_R1), MV(ws) + 1 * D, P_HB(ws)); SEAM(); }
            } else {
                if (EN(3) && IN(ph + 0)) REPS(3) { const auto* ap = KARG(); unsigned char* ws = ap->ws; MKFRAME(F, ws); const bool dry = (rep_ == 0) && ((DBG_DUP >> 3) & 1);
                    norm_proj_phase<true>(F, P_XB(ws), dry ? (bf16*)(ws + WS_ACT) : P_XB(ws), P_YS(ws), MVP(ws) + 5 * D, MV(ws) + 1 * D, MV(ws) + 0 * D, ap->in[8] + (size_t)jx * D * FOX_LD + NQKV, FOX_LD, ap->in[9] + jx * NH, dry ? (bf16*)(ws + WS_K) : P_HB(ws), (float*)(ws + (dry ? WS_FB : WS_LF)), nullptr, nullptr, nullptr); SEAM(); }
                if (EN(4) && IN(ph + 1)) {
                    REPS(4) { const auto* ap = KARG(); unsigned char* ws = ap->ws; MKFRAME(F, ws);
                    fox_scan(F, (const float*)(ws + WS_LF), (float*)(ws + WS_FB));
                    pg8::SchedDenseT<true> S{(const char*)P_HB(ws), (const char*)(ws + WS_WQKV) + (size_t)jx * NQKV * D, (size_t)256 * D, (size_t)256 * D, 0, T / 256, NQKV / 256, F.G, F.bid};
                    pg8::EpiQKV E{(bf16*)(ws + WS_Q), (size_t)(WS_K - WS_Q) / 2, attn_body::C2, 1.0f / (pg8::FP8_SA * pg8::FP8_SW), (unsigned*)(F.ctl + CW_QN2) + jx * 4096, (unsigned*)(F.ctl + CW_KN2) + jx * 128};
                    pg8::gemm_phase<pg8::EpiQKV, pg8::SchedDenseT<true>, true, true>(F.lds + RING_OFF, F.lds + IDX_OFF, D / 128, D, D, S, E); SEAM(); }
                }
                if (EN(5) && IN(ph + 2)) {
                    static_assert(attn_body::ATTN_LDS_BYTES <= RING_BYTES && attn_body::ATTN_PITCH == D, "attention body geometry vs frame");
                    REPS(5) { const auto* ap = KARG(); unsigned char* ws = ap->ws; gu32* ctl = (gu32*)(ws + WS_CTL);
                    const attn_body::AttnTensors AT{(const attn_body::bf16*)(ws + WS_Q), (const attn_body::bf16*)(ws + WS_K), (const attn_body::bf16*)(ws + WS_V), (attn_body::bf16*)(ws + WS_HB), (const float*)(ws + WS_FB), (const unsigned*)(ctl + CW_QN2) + jx * 4096, (const unsigned*)(ctl + CW_KN2) + jx * 128};
                    int g_ = gridDim.x, b_ = blockIdx.x; asm volatile("" : "+s"(g_), "+s"(b_)); const attn_body::StaticOrder S(g_, b_);
                    attn_body::attn_phase<attn_body::StaticOrder>((char*)lds + RING_OFF, AT, S, (volatile LAS int*)((LAS unsigned char*)lds + SCHED_OFF)); SEAM(); }
                }
            }
            if (EN(6) && IN(ph + (odd ? 3 : 2))) REPS(6) { const auto* ap = KARG(); unsigned char* ws = ap->ws; MKFRAME(F, ws); const bool dry = (rep_ == 0) && ((DBG_DUP >> 6) & 1);
                if (!odd) {
                    pg8::SchedDense S{(const char*)P_HB(ws), (const char*)((bf16*)(ws + WS_WPOOL) + (size_t)jx * 4 * 65536), (size_t)256 * D * 2, (size_t)256 * 256 * 2, 512, T / 256, 4, F.G, F.bid};
                    pg8::EpiResid E{(L == 0) ? (const void*)ap->in[0] : (const void*)P_XB(ws), L != 0, dry ? (bf16*)(ws + WS_ACT) : P_XB(ws), MV(ws) + 2 * D, 6 * D, 1.0f};
                    pg8::gemm_phase<pg8::EpiResid, pg8::SchedDense, true, false>(F.lds + RING_OFF, F.lds + IDX_OFF, 256 / 64, D * 2, 256 * 2, S, E);
                } else {
                    pg8::SchedDenseT<true> S{(const char*)P_HB(ws), (const char*)(ws + WS_WO) + (size_t)jx * D * D, (size_t)256 * D, (size_t)256 * D, 0, T / 256, 4, F.G, F.bid};
                    pg8::EpiResid E{(const void*)P_XB(ws), true, dry ? (bf16*)(ws + WS_ACT) : P_XB(ws), MV(ws) + 2 * D, 6 * D, 1.0f / (attn_body::O_SCALE * pg8::FP8_SW)};
                    pg8::gemm_phase<pg8::EpiResid, pg8::SchedDenseT<true>, true, true>(F.lds + RING_OFF, F.lds + IDX_OFF, D / 128, D, D, S, E);
                }
                SEAM();
            }
        }
        if (do_moe) {
            const int pm = ph + (odd ? 4 : 3);
            if (EN(7) && IN(pm + 0)) REPS(7) { const auto* ap = KARG(); unsigned char* ws = ap->ws; MKFRAME(F, ws); const bool dry = (rep_ == 0) && ((DBG_DUP >> 7) & 1);
                norm_proj_phase<false>(F, P_XB(ws), nullptr, nullptr, nullptr, MV(ws) + 4 * D, MV(ws) + 3 * D, ap->in[11] + (size_t)L * D * NEXP, NEXP, ap->in[12] + L * NEXP, P_HB(ws), nullptr, (unsigned*)(F.ctl + CW_GCNT) + L * NEXP, (int*)(ws + WS_SLOTP), (float*)(ws + WS_SLOTG), dry); SEAM(); }
            if (EN(8) && IN(pm + 1)) { REPS(8) { const auto* ap = KARG(); unsigned char* ws = ap->ws; MKFRAME(F, ws);
                moe_setup(F, (unsigned*)(F.ctl + CW_GCNT) + L * NEXP, 2 * FF / 256);
                pg8::SchedMoe<true, false> S{(const char*)P_HB(ws), (const char*)(ws + WS_W1) + (size_t)L * NEXP * 2 * FF * D, 0, (size_t)2 * FF * D, (size_t)256 * D, (const int*)(ws + WS_SLOTP), (const float*)(ws + WS_SLOTG), ap->in[14] + (size_t)L * NEXP * 2 * FF, (const LAS int*)(F.lds + UL_OFF)};
                pg8::EpiSwiglu E{(unsigned char*)(ws + WS_ACT), 1.0f / (pg8::FP8_SA * pg8::FP8_SW)};
                pg8::gemm_phase<pg8::EpiSwiglu, pg8::SchedMoe<true, false>, true, true>(F.lds + RING_OFF, F.lds + IDX_OFF, D / 128, D, D, S, E); SEAM(); } }
            if (EN(9) && IN(pm + 2)) { REPS(9) { const auto* ap = KARG(); unsigned char* ws = ap->ws; MKFRAME(F, ws);
                moe_setup(F, (unsigned*)(F.ctl + CW_GCNT) + L * NEXP, D / 256, (MK_N_LAUNCHES == 1) && EN(8) && (DBG_DUP == 0));
                pg8::SchedMoe<false, true> S{(const char*)(ws + WS_ACT), (const char*)(ws + WS_W2) + (size_t)L * NEXP * D * FF, (size_t)256 * FF, (size_t)D * FF, (size_t)256 * FF, (const int*)(ws + WS_SLOTP), (const float*)(ws + WS_SLOTG), ap->in[16] + (size_t)L * NEXP * D, (const LAS int*)(F.lds + UL_OFF)};
                pg8::EpiScatter E{P_YS(ws), 1.0f / (pg8::FP8_SA * pg8::FP8_SW)};
                pg8::gemm_phase<pg8::EpiScatter, pg8::SchedMoe<false, true>, true, true>(F.lds + RING_OFF, F.lds + IDX_OFF, FF / 128, FF, FF, S, E); SEAM(); } }
        }
    }
    if (EN(10) && IN(PH_FINAL)) REPS(10) { const auto* ap = KARG(); unsigned char* ws = ap->ws; MKFRAME(F, ws); const bool dry = (rep_ == 0) && ((DBG_DUP >> 10) & 1);
        constexpr bool fin_comb = (MK_NBRANCH > 0) && (MK_NBRANCH % 2 == 0);
        constexpr int Lc = fin_comb ? MK_NBRANCH / 2 - 1 : 0;
        if (rep_ == 1) SEAM();
        static_assert(MK_NBRANCH > 0, "the final phase reads the bf16 working stream");
        rows_phase<1, true>(F, fin_comb, P_XB(ws), dry ? (void*)(ws + WS_ACT) : (void*)ap->out, P_YS(ws), P_MODV(ws) + (size_t)Lc * BATCH * 6 * D + 5 * D, nullptr, ap->in[17]);
    }
#undef IN
#undef SEAM
}

extern "C" void kernel_launch(void* const* d_in, const int* in_sizes, int n_in, void* d_out, int out_size, void* d_ws, size_t ws_size, hipStream_t stream) {
    static int grid = 0;
    if (grid == 0) {
        if (n_in != 18 || in_sizes[0] != T * D || out_size != T * D || ws_size < WS_END) { fprintf(stderr, "kernel_launch: unexpected shapes / workspace (n_in %d, in0 %d, out %d, ws %zu, need %zu); nothing launched\n", n_in, n_in > 0 ? in_sizes[0] : -1, out_size, ws_size, (size_t)WS_END); grid = -1; return; }
        int dev = 0, cus = 0, per_cu = 0;
        if (hipGetDevice(&dev) != hipSuccess || hipDeviceGetAttribute(&cus, hipDeviceAttributeMultiprocessorCount, dev) != hipSuccess) { fprintf(stderr, "kernel_launch: device query failed\n"); grid = -1; return; }
        if (hipFuncSetAttribute((const void*)enc_fwd, hipFuncAttributeMaxDynamicSharedMemorySize, LDS_BYTES) != hipSuccess) { fprintf(stderr, "kernel_launch: hipFuncSetAttribute failed\n"); grid = -1; return; }
        if (hipOccupancyMaxActiveBlocksPerMultiprocessor(&per_cu, (const void*)enc_fwd, NWAVES * 64, LDS_BYTES) != hipSuccess || per_cu < 1)
            fprintf(stderr, "kernel_launch: note: occupancy query reports %d workgroups per CU\n", per_cu);
        (void)hipGetLastError();
        grid = cus;
        if (grid != 256) fprintf(stderr, "kernel_launch: %d CUs (built and tuned for 256)\n", grid);
    }
    if (grid < 0) return;
    if (hipMemsetAsync((char*)d_ws + WS_CTL, 0, CTL_ZERO_BYTES, stream) != hipSuccess) { fprintf(stderr, "kernel_launch: hipMemsetAsync failed\n"); return; }
    Args a{};
    for (int i = 0; i < 18; ++i) a.in[i] = (const float*)d_in[i];
    a.out = (float*)d_out; a.ws = (unsigned char*)d_ws;
#if MK_N_LAUNCHES == 1
    a.ph_lo = 0; a.ph_hi = NPH;
    hipLaunchKernelGGL(enc_fwd, dim3(grid), dim3(NWAVES * 64), LDS_BYTES, stream, a);
    { const hipError_t le = hipPeekAtLastError(); if (le != hipSuccess) fprintf(stderr, "kernel_launch: launch failed: %s\n", hipGetErrorName(le)); }
#else
    for (int ph = 0; ph < NPH; ++ph) {
        if (ph > 0 && ph < PH_FINAL) { const int L = (ph - 1) / 8, p = (ph - 1) % 8; if (p >= ((L & 1) ? 7 : 6)) continue; }
        a.ph_lo = ph; a.ph_hi = ph + 1;
        hipLaunchKernelGGL(enc_fwd, dim3(grid), dim3(NWAVES * 64), LDS_BYTES, stream, a);
        const hipError_t le = hipPeekAtLastError(); if (le != hipSuccess) { fprintf(stderr, "kernel_launch: launch %d failed: %s\n", ph, hipGetErrorName(le)); break; }
    }
#endif
}
```

```cpp
#include <hip/hip_runtime.h>
#include <hip/hip_bf16.h>
#include <cstdio>
#include <cstdint>
#include <cmath>

#ifndef MK_N_LAUNCHES
#define MK_N_LAUNCHES 1
#endif
#ifndef MK_NBRANCH
#define MK_NBRANCH 8
#endif

constexpr int D = 1024, BATCH = 4, SEQ = 8192, T = BATCH * SEQ, DEPTH = 4, NEXP = 32, TOPK = 4, NH = 16, HD = 64, FF = 1024;
constexpr int NQKV = 3 * D, FOX_LD = 3 * D + NH;
constexpr float EPS = 1e-6f;
constexpr int MAXMT = T * TOPK / 256 + NEXP;

#define GAS __attribute__((address_space(1)))
#define LAS __attribute__((address_space(3)))

namespace pg8 {
#define PG8_LAS __attribute__((address_space(3)))
typedef unsigned short bf16_t;
typedef short bf16x8 __attribute__((ext_vector_type(8)));
typedef float f32x4 __attribute__((ext_vector_type(4)));
typedef float f32x2 __attribute__((ext_vector_type(2)));
typedef unsigned u32x4 __attribute__((ext_vector_type(4)));
typedef unsigned u32x2 __attribute__((ext_vector_type(2)));
typedef int v4i __attribute__((ext_vector_type(4)));
typedef int v8i __attribute__((ext_vector_type(8)));
constexpr int BM = 256, BK = 64, HALF = 128, HTB = HALF * BK * 2, STAGE_BYTES = 8 * HTB, NXCD = 8, WGM = 4;
constexpr int IDX_BYTES = 9216;

__host__ __device__ __forceinline__ int lds_byte(int r, int c) { const int st = (r >> 4) * 2 + (c >> 5), rr = r & 15, cc = c & 31, ob = rr * 64 + cc * 2; return st * 1024 + (ob ^ (((ob >> 9) & 1) << 5)); }
__host__ __device__ __forceinline__ void stage_rc(int b, int& R, int& C) { const int st = b / 1024, sb = b % 1024, swz = sb ^ (((sb >> 9) & 1) << 5); R = (st >> 1) * 16 + swz / 64; C = (st & 1) * 32 + (swz % 64) / 2; }
__host__ __device__ __forceinline__ int perm32(int rho) { const int n = rho >> 4, i = rho & 15; return 8 * (i >> 2) + 4 * n + (i & 3); }

__device__ __forceinline__ f32x4 zero4() { float z0, z1, z2, z3; asm volatile("v_mov_b32 %0, 0\n\tv_mov_b32 %1, 0\n\tv_mov_b32 %2, 0\n\tv_mov_b32 %3, 0" : "=v"(z0), "=v"(z1), "=v"(z2), "=v"(z3)); return (f32x4){z0, z1, z2, z3}; }
struct Unit { int pm, pn, e, cnt, mloc; };

__device__ __forceinline__ unsigned cvt_pk_bf16(float lo, float hi) { unsigned r; asm volatile("v_cvt_pk_bf16_f32 %0, %1, %2" : "=v"(r) : "v"(lo), "v"(hi)); return r; }

__device__ __forceinline__ float clamp448(float x) { return __builtin_amdgcn_fmed3f(x, -448.0f, 448.0f); }
__device__ __forceinline__ unsigned pk4_fp8(float a, float b, float c, float d) { int w; asm volatile("v_mov_b32 %0, 0" : "=v"(w));
    w = __builtin_amdgcn_cvt_pk_fp8_f32(clamp448(a), clamp448(b), w, false); w = __builtin_amdgcn_cvt_pk_fp8_f32(clamp448(c), clamp448(d), w, true); return (unsigned)w; }
constexpr float FP8_SW = 64.0f, FP8_SA = 4.0f;

__device__ __forceinline__ bool tile_order(int i, int G, int c, int nM, int nN, int& pm, int& pn) {
    const int nwg = nM * nN; const long L = (long)i * G + c; if (L >= nwg) return false;
    int wgid = (int)L; { const int q = nwg / NXCD, r = nwg % NXCD, xcd = wgid % NXCD, off = wgid / NXCD; wgid = (xcd < r ? xcd * (q + 1) : r * (q + 1) + (xcd - r) * q) + off; }
    const int nig = WGM * nN, gid = wgid / nig, fm = gid * WGM, gsz = (nM - fm) < WGM ? (nM - fm) : WGM;
    pm = fm + ((wgid % nig) % gsz); pn = (wgid % nig) / gsz; return true;
}

template <bool RO = false> struct SchedDenseT {
    static constexpr bool IDX = false, GATHER_A = false, GATE = false, ROWOFF_A = RO;
    const char* A; const char* Bt; size_t tstepA, tstepB; int a_pn_bytes; int nM, nN, G, c;
    __device__ __forceinline__ bool next(int i, Unit& u) const { u.e = 0; u.cnt = 256; u.mloc = 0; return tile_order(i, G, c, nM, nN, u.pm, u.pn); }
    __device__ __forceinline__ void ptrs(const Unit& u, const char*& cA, const char*& cB) const { cA = A + (RO ? (size_t)0 : (size_t)u.pm * tstepA) + (size_t)u.pn * a_pn_bytes; cB = Bt + (size_t)u.pn * tstepB; }
    __device__ __forceinline__ void issue_idx(const Unit&, PG8_LAS unsigned char*, int, int, int) const {}
};
typedef SchedDenseT<false> SchedDense;
template <bool GA, bool GT>
struct SchedMoe {
    static constexpr bool IDX = true, GATHER_A = GA, GATE = GT, ROWOFF_A = !GA;
    const char* A; const char* Bt; size_t tstepA, e_stepB, tstepB;
    const int* slot_pair; const float* slot_gate; const float* bias;
    const PG8_LAS int* ul;
    __device__ __forceinline__ bool next(int i, Unit& u) const {
        const PG8_LAS int* p = ul + 5 * i; const int pm = __builtin_amdgcn_readfirstlane(p[0]); if (pm < 0) return false;
        u.pm = pm; u.pn = __builtin_amdgcn_readfirstlane(p[1]); u.e = __builtin_amdgcn_readfirstlane(p[2]); u.cnt = __builtin_amdgcn_readfirstlane(p[3]); u.mloc = __builtin_amdgcn_readfirstlane(p[4]); return true;
    }
    __device__ __forceinline__ void ptrs(const Unit& u, const char*& cA, const char*& cB) const {
        cA = A; cB = Bt + (size_t)u.e * e_stepB + (size_t)u.pn * tstepB; }
    __device__ __forceinline__ void issue_idx(const Unit& u, PG8_LAS unsigned char* ldsx, int buf, int wid, int lane) const {
        asm volatile("" : "+v"(lane));
        int pos = u.mloc * 256 + (wid & 3) * 64 + lane; pos = pos < u.cnt ? pos : u.cnt - 1;
        const size_t off = (size_t)u.e * T + pos;
        if (wid < 4) __builtin_amdgcn_global_load_lds((const unsigned*)(slot_pair + off), (PG8_LAS unsigned*)(ldsx + buf * 1024 + wid * 256), 4, 0, 0);
        else if (GT) __builtin_amdgcn_global_load_lds((const unsigned*)(slot_gate + off), (PG8_LAS unsigned*)(ldsx + 3072 + buf * 1024 + (wid - 4) * 256), 4, 0, 0);
        if (GA) { if (wid >= 4) { const int w4 = wid - 4; const float* bp = bias + (size_t)u.e * 2048 + (w4 >> 1) * 1024 + u.pn * 128 + (w4 & 1) * 64 + lane;
                    __builtin_amdgcn_global_load_lds((const unsigned*)bp, (PG8_LAS unsigned*)(ldsx + 6144 + buf * 1024 + w4 * 256), 4, 0, 0); } }
        else { if (wid < 4) { const float* bp = bias + (size_t)u.e * 1024 + u.pn * 256 + wid * 64 + lane;
                    __builtin_amdgcn_global_load_lds((const unsigned*)bp, (PG8_LAS unsigned*)(ldsx + 6144 + buf * 1024 + wid * 256), 4, 0, 0); } }
    }
};

template <int CTRL> __device__ __forceinline__ float dpp_maxf(float v) { return fmaxf(v, __builtin_bit_cast(float, __builtin_amdgcn_update_dpp(0, __builtin_bit_cast(int, v), CTRL, 0xF, 0xF, false))); }
struct EpiQKV {
    static constexpr int PERM = 1;
    bf16_t* O; size_t split_stride; float scale0, sall; unsigned* qn2; unsigned* kn2;
    __device__ __forceinline__ void operator()(const f32x4 (&acc)[2][2][4][2], const Unit& u, int wr, int wc, int fr, int fq, PG8_LAS unsigned char*, int) const {
        const int row0 = u.pm * BM + wr * 64 + fr; int colt = u.pn * BM; const int t = colt / 1024; bf16_t* base = O + (size_t)t * split_stride; colt -= t * 1024;
        const float sc = ((t == 0) ? scale0 : 1.f) * sall; const int col0 = colt + wc * 32 + 8 * fq;
        float mx[2] = {0.f, 0.f};
#pragma unroll
        for (int ai = 0; ai < 2; ++ai)
#pragma unroll
            for (int m = 0; m < 4; ++m) { bf16_t* rowp = base + (size_t)(row0 + ai * HALF + m * 16) * 1024 + col0;
#pragma unroll
                for (int bj = 0; bj < 2; ++bj) { const f32x4 v0 = acc[ai][bj][m][0] * sc, v1 = acc[ai][bj][m][1] * sc;
                    u32x4 w; w.x = cvt_pk_bf16(v0[0], v0[1]); w.y = cvt_pk_bf16(v0[2], v0[3]); w.z = cvt_pk_bf16(v1[0], v1[1]); w.w = cvt_pk_bf16(v1[2], v1[3]);
                    *(u32x4*)(rowp + bj * HALF) = w;
                    if (t < 2) { float ss = (v0[0] * v0[0] + v0[1] * v0[1]) + (v0[2] * v0[2] + v0[3] * v0[3]) + (v1[0] * v1[0] + v1[1] * v1[1]) + (v1[2] * v1[2] + v1[3] * v1[3]);
                        { const auto r = __builtin_amdgcn_permlane16_swap(__float_as_uint(ss), __float_as_uint(ss), false, false); ss = __uint_as_float(r[0]) + __uint_as_float(r[1]); }
                        { const auto r = __builtin_amdgcn_permlane32_swap(__float_as_uint(ss), __float_as_uint(ss), false, false); ss = __uint_as_float(r[0]) + __uint_as_float(r[1]); }
                        mx[bj] = fmaxf(mx[bj], ss); } } }
        if (t < 2) {
#pragma unroll
            for (int bj = 0; bj < 2; ++bj) { float m_ = mx[bj]; m_ = dpp_maxf<0xB1>(m_); m_ = dpp_maxf<0x4E>(m_); m_ = dpp_maxf<0x141>(m_); m_ = dpp_maxf<0x140>(m_);
                if (fr == 0 && fq == 0) { const int bh = (u.pm >> 5) * 16 + (colt >> 6) + bj * 2 + (wc >> 1), half = wc & 1;
                    if (t == 0) __hip_atomic_fetch_max(qn2 + ((size_t)bh * 32 + (u.pm & 31)) * 2 + half, __float_as_uint(m_), __ATOMIC_RELAXED, __HIP_MEMORY_SCOPE_AGENT);
                    else        __hip_atomic_fetch_max(kn2 + (size_t)bh * 2 + half, __float_as_uint(m_), __ATOMIC_RELAXED, __HIP_MEMORY_SCOPE_AGENT); } }
        }
    }
};
struct EpiResid {
    static constexpr int PERM = 1;
    const void* src; bool src_bf; bf16_t* dst; const float* cs; int cs_bstride; float s;
    __device__ __forceinline__ void operator()(const f32x4 (&acc)[2][2][4][2], const Unit& u, int wr, int wc, int fr, int fq, PG8_LAS unsigned char*, int) const {
        const int row0 = u.pm * BM + wr * 64 + fr, col0 = u.pn * BM + wc * 32 + 8 * fq; const int b = (u.pm * BM) / SEQ;
        f32x4 cv[2][2];
#pragma unroll
        for (int bj = 0; bj < 2; ++bj)
#pragma unroll
            for (int n = 0; n < 2; ++n) cv[bj][n] = *(const f32x4*)(cs + (size_t)b * cs_bstride + col0 + bj * HALF + 4 * n) * s;
        if (src_bf) {
            u32x4 wq[2][4];
#define ER_OFF(bt, mm) ((size_t)(row0 + ((bt) >> 1) * HALF + (2 * ((bt) & 1) + (mm)) * 16) * 1024 + col0)
#define ER_LD(bt, W) do { _Pragma("unroll") for (int mm = 0; mm < 2; ++mm) { _Pragma("unroll") for (int bj = 0; bj < 2; ++bj) W[mm * 2 + bj] = *(const u32x4*)((const bf16_t*)src + ER_OFF(bt, mm) + bj * HALF); } } while (0)
#define ER_ST(bt, W) do { _Pragma("unroll") for (int mm = 0; mm < 2; ++mm) { _Pragma("unroll") for (int bj = 0; bj < 2; ++bj) { const u32x4 w = W[mm * 2 + bj]; \
                const f32x4 x0 = (f32x4){__uint_as_float(w.x << 16), __uint_as_float(w.x & 0xffff0000u), __uint_as_float(w.y << 16), __uint_as_float(w.y & 0xffff0000u)}; \
                const f32x4 x1 = (f32x4){__uint_as_float(w.z << 16), __uint_as_float(w.z & 0xffff0000u), __uint_as_float(w.w << 16), __uint_as_float(w.w & 0xffff0000u)}; \
                const f32x4 y0 = x0 + cv[bj][0] * acc[(bt) >> 1][bj][2 * ((bt) & 1) + mm][0], y1 = x1 + cv[bj][1] * acc[(bt) >> 1][bj][2 * ((bt) & 1) + mm][1]; \
                u32x4 o; o.x = cvt_pk_bf16(y0[0], y0[1]); o.y = cvt_pk_bf16(y0[2], y0[3]); o.z = cvt_pk_bf16(y1[0], y1[1]); o.w = cvt_pk_bf16(y1[2], y1[3]); \
                *(u32x4*)(dst + ER_OFF(bt, mm) + bj * HALF) = o; } } } while (0)
            ER_LD(0, wq[0]); ER_LD(1, wq[1]); asm volatile("" ::: "memory");
            ER_ST(0, wq[0]); ER_LD(2, wq[0]); asm volatile("" ::: "memory");
            ER_ST(1, wq[1]); ER_LD(3, wq[1]); asm volatile("" ::: "memory");
            ER_ST(2, wq[0]); asm volatile("" ::: "memory");
            ER_ST(3, wq[1]);
#undef ER_OFF
#undef ER_LD
#undef ER_ST
            return;
        }
#pragma unroll
        for (int ai = 0; ai < 2; ++ai)
#pragma unroll
            for (int m = 0; m < 4; ++m) { const size_t off = (size_t)(row0 + ai * HALF + m * 16) * 1024 + col0;
#pragma unroll
                for (int bj = 0; bj < 2; ++bj) { f32x4 x0, x1;
                    if (src_bf) { const u32x4 w = *(const u32x4*)((const bf16_t*)src + off + bj * HALF);
                        x0 = (f32x4){__uint_as_float(w.x << 16), __uint_as_float(w.x & 0xffff0000u), __uint_as_float(w.y << 16), __uint_as_float(w.y & 0xffff0000u)};
                        x1 = (f32x4){__uint_as_float(w.z << 16), __uint_as_float(w.z & 0xffff0000u), __uint_as_float(w.w << 16), __uint_as_float(w.w & 0xffff0000u)}; }
                    else { x0 = *(const f32x4*)((const float*)src + off + bj * HALF); x1 = *(const f32x4*)((const float*)src + off + bj * HALF + 4); }
                    const f32x4 y0 = x0 + cv[bj][0] * acc[ai][bj][m][0], y1 = x1 + cv[bj][1] * acc[ai][bj][m][1];
                    u32x4 o; o.x = cvt_pk_bf16(y0[0], y0[1]); o.y = cvt_pk_bf16(y0[2], y0[3]); o.z = cvt_pk_bf16(y1[0], y1[1]); o.w = cvt_pk_bf16(y1[2], y1[3]);
                    *(u32x4*)(dst + off + bj * HALF) = o; }
                if (m & 1) asm volatile("" ::: "memory"); }
    }
};
constexpr float SWG_C = -1.702f * 1.4426950408889634f;
__device__ __forceinline__ f32x2 swiglu_pk(f32x2 tg, f32x2 uq) {
    tg.x = fmaxf(tg.x, 7.0f * SWG_C); tg.y = fmaxf(tg.y, 7.0f * SWG_C); uq.x = __builtin_amdgcn_fmed3f(uq.x, 32.0f / SWG_C, -24.0f / SWG_C); uq.y = __builtin_amdgcn_fmed3f(uq.y, 32.0f / SWG_C, -24.0f / SWG_C);
    f32x2 d; d.x = __builtin_amdgcn_exp2f(tg.x); d.y = __builtin_amdgcn_exp2f(tg.y); d = d + 1.0f;
    f32x2 r; r.x = __builtin_amdgcn_rcpf(d.x); r.y = __builtin_amdgcn_rcpf(d.y);
    return (tg * r) * uq;
}
__device__ __forceinline__ unsigned pk4_fp8_raw(f32x2 a, f32x2 b) { int w; asm volatile("v_mov_b32 %0, 0" : "=v"(w)); w = __builtin_amdgcn_cvt_pk_fp8_f32(a.x, a.y, w, false); w = __builtin_amdgcn_cvt_pk_fp8_f32(b.x, b.y, w, true); return (unsigned)w; }
struct EpiSwiglu {
    static constexpr int PERM = 1;
    unsigned char* act; float s;
    __device__ __forceinline__ void operator()(const f32x4 (&acc)[2][2][4][2], const Unit& u, int wr, int wc, int fr, int fq, PG8_LAS unsigned char* ldsx, int buf) const {
        const int row0 = u.pm * BM + wr * 64 + fr, colh = u.pn * HALF + wc * 32 + 8 * fq;
        const PG8_LAS float* bb = (const PG8_LAS float*)(ldsx + 6144 + buf * 1024) + wc * 32 + 8 * fq;
        const float sg = s * SWG_C, su = s * (FP8_SA / SWG_C);
        const f32x4 bg0 = *(const PG8_LAS f32x4*)(bb) * SWG_C, bg1 = *(const PG8_LAS f32x4*)(bb + 4) * SWG_C, bu0 = (*(const PG8_LAS f32x4*)(bb + 128) + 1.0f) * (FP8_SA / SWG_C), bu1 = (*(const PG8_LAS f32x4*)(bb + 132) + 1.0f) * (FP8_SA / SWG_C);
        static_assert(FP8_SA == 4.0f, "swiglu_pk folds the activation scale 4");
        const int fqe = fq & ~1, rsel = fq & 1;
#pragma unroll
        for (int ai = 0; ai < 2; ++ai)
#pragma unroll
            for (int mp = 0; mp < 2; ++mp) {
                u32x2 w[2];
#pragma unroll
                for (int mm = 0; mm < 2; ++mm) { const int m = 2 * mp + mm;
                    const f32x4 g0 = acc[ai][0][m][0] * sg + bg0, g1 = acc[ai][0][m][1] * sg + bg1, u0 = acc[ai][1][m][0] * su + bu0, u1 = acc[ai][1][m][1] * su + bu1;
                    w[mm].x = pk4_fp8_raw(swiglu_pk((f32x2){g0[0], g0[1]}, (f32x2){u0[0], u0[1]}), swiglu_pk((f32x2){g0[2], g0[3]}, (f32x2){u0[2], u0[3]}));
                    w[mm].y = pk4_fp8_raw(swiglu_pk((f32x2){g1[0], g1[1]}, (f32x2){u1[0], u1[1]}), swiglu_pk((f32x2){g1[2], g1[3]}, (f32x2){u1[2], u1[3]})); }
                const auto rx = __builtin_amdgcn_permlane16_swap(w[0].x, w[1].x, false, false); const auto ry = __builtin_amdgcn_permlane16_swap(w[0].y, w[1].y, false, false);
                u32x4 o; o.x = rx[0]; o.y = ry[0]; o.z = rx[1]; o.w = ry[1];
                *(u32x4*)(act + (size_t)(row0 + ai * HALF + (2 * mp + rsel) * 16) * 1024 + u.pn * HALF + wc * 32 + 8 * fqe) = o; }
    }
};
constexpr float YS_SCALE = 16.0f;
struct EpiScatter {
    static constexpr int PERM = 2;
    unsigned char* ys; float s;
    __device__ __forceinline__ void operator()(const f32x4 (&acc)[2][2][4][2], const Unit& u, int wr, int wc, int fr, int fq, PG8_LAS unsigned char* ldsx, int buf) const {
        const PG8_LAS int* ip = (const PG8_LAS int*)(ldsx + buf * 1024); const PG8_LAS float* ig = (const PG8_LAS float*)(ldsx + 3072 + buf * 1024);
        const int cl = wc * 64 + 16 * fq; const PG8_LAS float* bb = (const PG8_LAS float*)(ldsx + 6144 + buf * 1024) + cl;
#pragma unroll
        for (int ai = 0; ai < 2; ++ai)
#pragma unroll
            for (int m = 0; m < 4; ++m) { const int rr = ai * HALF + wr * 64 + m * 16 + fr; const int pair = ip[rr]; const float gate = ig[rr] * YS_SCALE;
                u32x4 w;
#pragma unroll
                for (int bj = 0; bj < 2; ++bj)
#pragma unroll
                    for (int n = 0; n < 2; ++n) { const f32x4 bvv = *(const PG8_LAS f32x4*)(bb + 8 * bj + 4 * n); const f32x4 v = (acc[ai][bj][m][n] * s + bvv) * gate; w[bj * 2 + n] = pk4_fp8(v[0], v[1], v[2], v[3]); }
                const unsigned off = (unsigned)pair * 1024u + (unsigned)(u.pn * BM + cl);
                asm volatile("global_store_dwordx4 %0, %1, %2" :: "v"(off), "v"(w), "s"(ys) : "memory"); }
    }
};

__device__ __forceinline__ void glds16s(unsigned voff, const char* base, unsigned ldsaddr) { unsigned keep;
    asm volatile("s_mov_b32 %0, m0\n\ts_mov_b32 m0, %3\n\ts_nop 0\n\tglobal_load_lds_dwordx4 %1, %2\n\ts_mov_b32 m0, %0" : "=&s"(keep) : "v"(voff), "s"(base), "s"(ldsaddr) : "memory"); }
template <class Epi, class Sched, bool ALIGN_EPI, bool FP8>
__device__ __forceinline__ void gemm_phase(PG8_LAS unsigned char* lds, PG8_LAS unsigned char* ldsx, const int nt, const int ldaB, const int ldbB, const Sched& S, const Epi& E) {
    int tid = threadIdx.x; asm volatile("" : "+v"(tid));
    const int wid = __builtin_amdgcn_readfirstlane(tid >> 6), lane = tid & 63, wr = wid >> 2, wc = wid & 3, fr = lane & 15, fq = lane >> 4;
    int R0, C0; stage_rc(tid * 16, R0, C0);
    unsigned vA[2][2], voffB[2];
#pragma unroll
    for (int i = 0; i < 2; ++i) { const int R = R0 + 64 * i;
        const int Rb = (Epi::PERM == 1) ? ((R & ~31) + perm32(R & 31)) : (Epi::PERM == 2) ? (64 * (R >> 5) + 16 * ((R & 15) >> 2) + 4 * ((R >> 4) & 1) + (R & 3)) : R;
        voffB[i] = (unsigned)(Rb * ldbB + C0 * 2); vA[0][i] = (unsigned)(R * ldaB + C0 * 2); vA[1][i] = (unsigned)((R + HALF) * ldaB + C0 * 2); }
    const size_t kstep = (size_t)(BK * 2);
    constexpr int H1 = (Sched::GATHER_A || Sched::ROWOFF_A) ? 1 : 0;
    const size_t hstepA = (Sched::GATHER_A || Sched::ROWOFF_A) ? (size_t)0 : (size_t)HALF * ldaB;
    const size_t hstepB = (size_t)(Epi::PERM == 2 ? 8 : HALF) * ldbB;
    const unsigned lds32 = (unsigned)(__UINTPTR_TYPE__)lds + (unsigned)wid * 1024u;
    const int aoff = lds_byte(wr * 64 + fr, fq * 8), boff = lds_byte(wc * 32 + fr, fq * 8);
#define PG8_SA(b, h) (((b) * 2 + (h)) * HTB)
#define PG8_SB(b, h) ((4 + (b) * 2 + (h)) * HTB)
#define PG8_STAGE(bufoff, gbase, voff) do { _Pragma("unroll") for (int _i = 0; _i < 2; ++_i) glds16s((voff)[_i], (const char*)(gbase), lds32 + (unsigned)((bufoff) + _i * 8192)); } while (0)
#define PG8_LD8(p) __builtin_shufflevector(*(const PG8_LAS v4i*)(p), *(const PG8_LAS v4i*)((p) + 1024), 0, 1, 2, 3, 4, 5, 6, 7)
#define PG8_LDA(dst, b, h) do { if constexpr (FP8) { _Pragma("unroll") for (int m = 0; m < 4; ++m) dst##8[m] = PG8_LD8(lds + PG8_SA(b, h) + aoff + m * 2048); } \
        else { _Pragma("unroll") for (int m = 0; m < 4; ++m) _Pragma("unroll") for (int k = 0; k < 2; ++k) dst[m][k] = *(const PG8_LAS bf16x8*)(lds + PG8_SA(b, h) + aoff + m * 2048 + k * 1024); } } while (0)
#define PG8_LDB(dst, b, h) do { if constexpr (FP8) { _Pragma("unroll") for (int n = 0; n < 2; ++n) dst##8[n] = PG8_LD8(lds + PG8_SB(b, h) + boff + n * 2048); } \
        else { _Pragma("unroll") for (int n = 0; n < 2; ++n) _Pragma("unroll") for (int k = 0; k < 2; ++k) dst[n][k] = *(const PG8_LAS bf16x8*)(lds + PG8_SB(b, h) + boff + n * 2048 + k * 1024); } } while (0)
#define PG8_MMA(ai, bj, At, Bt) do { __builtin_amdgcn_s_setprio(1); \
        if constexpr (FP8) { _Pragma("unroll") for (int m = 0; m < 4; ++m) _Pragma("unroll") for (int n = 0; n < 2; ++n) \
            acc[ai][bj][m][n] = __builtin_amdgcn_mfma_scale_f32_16x16x128_f8f6f4(Bt##8[n], At##8[m], acc[ai][bj][m][n], 0, 0, 0, 0, 0, 0); } \
        else { _Pragma("unroll") for (int m = 0; m < 4; ++m) _Pragma("unroll") for (int n = 0; n < 2; ++n) _Pragma("unroll") for (int k = 0; k < 2; ++k) \
            acc[ai][bj][m][n] = __builtin_amdgcn_mfma_f32_16x16x32_bf16(Bt[n][k], At[m][k], acc[ai][bj][m][n], 0, 0, 0); } \
        __builtin_amdgcn_s_setprio(0); } while (0)
#define PG8_WAIT_V(n) asm volatile("s_waitcnt vmcnt(" #n ")" ::: "memory")
#define PG8_WAIT_L(n) asm volatile("s_waitcnt lgkmcnt(" #n ")" ::: "memory")
#define PG8_BAR __builtin_amdgcn_s_barrier()
#define PG8_SCHED __builtin_amdgcn_sched_barrier(0)
#define PG8_GATHER(dst, buf) do { const PG8_LAS int* _ip = (const PG8_LAS int*)(ldsx + (buf) * 1024); _Pragma("unroll") for (int _h = 0; _h < 2; ++_h) _Pragma("unroll") for (int _i = 0; _i < 2; ++_i) \
        dst[_h][_i] = (unsigned)(_ip[_h * HALF + R0 + 64 * _i] >> 2) * (unsigned)ldaB + (unsigned)(C0 * 2); } while (0)
#define PG8_ROWOFF(dst, pmv) do { _Pragma("unroll") for (int _h = 0; _h < 2; ++_h) _Pragma("unroll") for (int _i = 0; _i < 2; ++_i) \
        dst[_h][_i] = (unsigned)((pmv) * BM + _h * HALF + R0 + 64 * _i) * (unsigned)ldaB + (unsigned)(C0 * 2); } while (0)
    Unit cur, nxt; int ui = 0, bcur = 0;
    if (!S.next(0, cur)) return;
    f32x4 acc[2][2][4][2];
#pragma unroll
    for (int a = 0; a < 2; ++a)
#pragma unroll
        for (int b = 0; b < 2; ++b)
#pragma unroll
            for (int m = 0; m < 4; ++m)
#pragma unroll
                for (int n = 0; n < 2; ++n) acc[a][b][m][n] = zero4();
    bf16x8 At[4][2], B0[2][2], B1[2][2]; v8i At8[4], B08[2], B18[2];
    const char* cA; const char* cB; S.ptrs(cur, cA, cB);
    const int kmask = nt - 1;
#define PG8_K0(u) (((u).pm + 2 * (u).pn) & kmask)
    int k0 = PG8_K0(cur);
    if constexpr (Sched::IDX) {
        S.issue_idx(cur, ldsx, 0, wid, lane);
        PG8_STAGE(PG8_SB(0, 0), cB + (size_t)k0 * kstep, voffB); PG8_STAGE(PG8_SB(0, 1), cB + hstepB + (size_t)k0 * kstep, voffB);
        PG8_WAIT_V(4); PG8_BAR; asm volatile("" ::: "memory");
        if constexpr (Sched::GATHER_A) { PG8_GATHER(vA, 0); PG8_WAIT_L(0); }
    }
    if constexpr (Sched::ROWOFF_A) { PG8_ROWOFF(vA, cur.pm); }
    { const size_t o0 = (size_t)k0 * kstep, o1 = (size_t)((k0 + 1) & kmask) * kstep;
    if constexpr (!Sched::IDX) { PG8_STAGE(PG8_SB(0, 0), cB + o0, voffB); PG8_STAGE(PG8_SB(0, 1), cB + hstepB + o0, voffB); }
    PG8_STAGE(PG8_SA(0, 0), cA + o0, vA[0]); PG8_STAGE(PG8_SA(0, 1), cA + hstepA + o0, vA[H1]);
    if (wr == 1) PG8_BAR;
    PG8_WAIT_V(2); PG8_BAR;
    PG8_STAGE(PG8_SB(1, 0), cB + o1, voffB); PG8_STAGE(PG8_SA(1, 0), cA + o1, vA[0]); PG8_STAGE(PG8_SB(1, 1), cB + hstepB + o1, voffB);
    PG8_WAIT_V(6); PG8_BAR; }
#pragma unroll 1
    for (;;) {
        const bool has_next = S.next(ui + 1, nxt);
        const int bnxt = (bcur == 2) ? 0 : bcur + 1;
        const char* nA = cA; const char* nB = cB;
        int k0n = k0;
        if (has_next) { S.ptrs(nxt, nA, nB); k0n = PG8_K0(nxt); if constexpr (Sched::IDX) S.issue_idx(nxt, ldsx, bnxt, wid, lane); }
#pragma unroll 1
        for (int t = 0; t < nt; t += 2) {
            const bool last = (t == nt - 2);
            const char* a1 = cA + (size_t)((t + 1 + k0) & kmask) * kstep;
            const size_t o2 = (size_t)((last ? k0n : t + 2 + k0) & kmask) * kstep, o3 = (size_t)((last ? k0n + 1 : t + 3 + k0) & kmask) * kstep;
            const char* a2 = (last ? nA : cA) + o2; const char* b2 = (last ? nB : cB) + o2;
            const char* a3 = (last ? nA : cA) + o3; const char* b3 = (last ? nB : cB) + o3;
            PG8_LDB(B0, 0, 0); PG8_LDB(B1, 0, 1); PG8_SCHED; PG8_LDA(At, 0, 0); PG8_STAGE(PG8_SA(1, 1), a1 + hstepA, vA[H1]);
            if constexpr (Sched::GATHER_A) { if (last && has_next) { PG8_GATHER(vA, bnxt); } }
            if constexpr (Sched::ROWOFF_A) { if (last && has_next) { PG8_ROWOFF(vA, nxt.pm); } }
            PG8_WAIT_V(8); PG8_WAIT_L(0); PG8_BAR; PG8_MMA(0, 0, At, B0); PG8_MMA(0, 1, At, B1); PG8_BAR; PG8_SCHED;
            PG8_LDA(At, 0, 1); PG8_STAGE(PG8_SB(0, 0), b2, voffB); PG8_STAGE(PG8_SB(0, 1), b2 + hstepB, voffB); PG8_STAGE(PG8_SA(0, 0), a2, vA[0]);
            PG8_WAIT_V(8); PG8_WAIT_L(0); PG8_BAR; PG8_MMA(1, 0, At, B0); PG8_MMA(1, 1, At, B1); PG8_BAR; PG8_SCHED;
            PG8_LDB(B0, 1, 0); PG8_LDB(B1, 1, 1); PG8_SCHED; PG8_LDA(At, 1, 0); PG8_STAGE(PG8_SA(0, 1), a2 + hstepA, vA[H1]);
            PG8_WAIT_V(8); PG8_WAIT_L(0); PG8_BAR; PG8_MMA(0, 0, At, B0); PG8_MMA(0, 1, At, B1); PG8_BAR; PG8_SCHED;
            PG8_LDA(At, 1, 1); PG8_STAGE(PG8_SB(1, 0), b3, voffB); PG8_STAGE(PG8_SB(1, 1), b3 + hstepB, voffB); PG8_STAGE(PG8_SA(1, 0), a3, vA[0]);
            PG8_WAIT_V(8); PG8_WAIT_L(0); PG8_BAR; PG8_MMA(1, 0, At, B0); PG8_MMA(1, 1, At, B1); PG8_BAR; PG8_SCHED;
        }
        if constexpr (ALIGN_EPI) { if (wr == 0) PG8_BAR; }
        { int tz = threadIdx.x; asm volatile("" : "+v"(tz));
          const int wid2 = __builtin_amdgcn_readfirstlane(tz >> 6), lane2 = tz & 63; E(acc, cur, wid2 >> 2, wid2 & 3, lane2 & 15, lane2 >> 4, ldsx, bcur); }
        if (!has_next) break;
#pragma unroll
        for (int a = 0; a < 2; ++a)
#pragma unroll
            for (int b = 0; b < 2; ++b)
#pragma unroll
                for (int m = 0; m < 4; ++m)
#pragma unroll
                    for (int n = 0; n < 2; ++n) acc[a][b][m][n] = zero4();
        cur = nxt; cA = nA; cB = nB; ++ui; bcur = bnxt; k0 = k0n;
        if constexpr (ALIGN_EPI) { if (wr == 1) PG8_BAR; }
    }
    PG8_WAIT_V(0);
    if constexpr (!ALIGN_EPI) { if (wr == 0) PG8_BAR; }
    PG8_BAR;
#undef PG8_SA
#undef PG8_SB
#undef PG8_STAGE
#undef PG8_LDA
#undef PG8_LDB
#undef PG8_MMA
#undef PG8_LD8
#undef PG8_WAIT_V
#undef PG8_WAIT_L
#undef PG8_BAR
#undef PG8_SCHED
#undef PG8_GATHER
#undef PG8_ROWOFF
#undef PG8_K0
}
}
#include <hip/hip_bf16.h>
#include <cmath>
namespace attn_body {
using bf16=__hip_bfloat16;
using bf16x8=__attribute__((ext_vector_type(8)))short;
using s16x4=__attribute__((ext_vector_type(4)))short;
using f32x16=__attribute__((ext_vector_type(16)))float;
using u32x4=__attribute__((ext_vector_type(4)))unsigned;
typedef float f32x4v __attribute__((ext_vector_type(4)));
constexpr int BATCH=4,NHEAD=16,SEQ=8192,D=64,DM=NHEAD*D;
constexpr int NW=8,QBLK=32,QB=QBLK*NW,KVBLK=64,NQB=SEQ/QB;
constexpr int ATTN_PITCH=DM, ATTN_UNIT_ROWS=QB;
__device__ __forceinline__ int crow(int r,int hi){return (r&3)+8*(r>>2)+4*hi;}
#define SBAR() __builtin_amdgcn_sched_barrier(0)
__device__ __forceinline__ void cmask(f32x16&p0,f32x16&p1,int jb,int qrel,int hi){
  const float NEG=-INFINITY; int kb=64*jb+4*hi;
  #pragma unroll
  for(int r=0;r<16;++r){int kv=kb+(r&3)+8*(r>>2); if(kv>qrel)p0[r]=NEG; if(kv+32>qrel)p1[r]=NEG;}
}

constexpr int NSLOT=3, SLOTB=8192;
constexpr int LDS_K=0, LDS_V=NSLOT*SLOTB, LDS_WS=2*NSLOT*SLOTB, LDS_OST=LDS_WS+NW*64*4, LDS_FB=LDS_OST+NW*4096, LDS_BYTES=LDS_FB+NW*1024;
constexpr float O_SCALE=16.0f;
constexpr float C2=0.125f*1.4426950408889634f;
__device__ __forceinline__ void glds16(const void*gsrc,unsigned lds_dst){unsigned keep;
  asm volatile("s_mov_b32 %0, m0\n\ts_mov_b32 m0, %2\n\ts_nop 0\n\tglobal_load_lds_dwordx4 %1, off\n\ts_mov_b32 m0, %0":"=&s"(keep):"v"(gsrc),"s"(lds_dst):"memory");}
__device__ __forceinline__ void glds4(const void*gsrc,unsigned lds_dst){unsigned keep;
  asm volatile("s_mov_b32 %0, m0\n\ts_mov_b32 m0, %2\n\ts_nop 0\n\tglobal_load_lds_dword %1, off\n\ts_mov_b32 m0, %0":"=&s"(keep):"v"(gsrc),"s"(lds_dst):"memory");}
__device__ __forceinline__ float max3f(float a,float b,float c){float r;asm("v_max3_f32 %0, %1, %2, %3":"=v"(r):"v"(a),"v"(b),"v"(c));return r;}
__device__ __forceinline__ float max2f(float a,float b){float r;asm("v_max_f32_e32 %0, %1, %2":"=v"(r):"v"(a),"v"(b));return r;}
__device__ __forceinline__ float fadd_s(float a,float b){float r;asm("v_add_f32_e32 %0, %1, %2":"=v"(r):"v"(a),"v"(b));return r;}
__device__ __forceinline__ float fsub_s(float a,float b){float r;asm("v_sub_f32_e32 %0, %1, %2":"=v"(r):"v"(a),"v"(b));return r;}
typedef float f32x2_t __attribute__((ext_vector_type(2))); typedef __bf16 bf16x2_t __attribute__((ext_vector_type(2)));
__device__ __forceinline__ unsigned cvtpk_s(float lo,float hi){f32x2_t v={lo,hi};bf16x2_t b=__builtin_convertvector(v,bf16x2_t);return __builtin_bit_cast(unsigned,b);}
#define WAIT_BAR(N) asm volatile("s_waitcnt vmcnt(" #N ") lgkmcnt(0)\n\ts_barrier":::"memory")

__device__ __forceinline__ void qkt(f32x16&p0,f32x16&p1,const char*Kslot,const bf16x8*qr,int r32,int hi){ const f32x16 negm=f32x16{};
  const char*kb=Kslot+hi*1024+r32*16;
  #pragma unroll
  for(int d0=0;d0<4;++d0){
    const bf16x8 b0=*reinterpret_cast<const bf16x8*>(kb+d0*2048);
    const bf16x8 b1=*reinterpret_cast<const bf16x8*>(kb+d0*2048+512);
    if(d0==0){p0=__builtin_amdgcn_mfma_f32_32x32x16_bf16(b0,qr[0],negm,0,0,0);p1=__builtin_amdgcn_mfma_f32_32x32x16_bf16(b1,qr[0],negm,0,0,0);}
    else{p0=__builtin_amdgcn_mfma_f32_32x32x16_bf16(b0,qr[d0],p0,0,0,0);p1=__builtin_amdgcn_mfma_f32_32x32x16_bf16(b1,qr[d0],p1,0,0,0);}}
}
typedef __attribute__((address_space(3))) const char* lds_cptr;
typedef short v4i16_t __attribute__((ext_vector_type(4)));
__device__ __forceinline__ void kload8(bf16x8*kf,lds_cptr kp){
  kf[0]=*(const __attribute__((address_space(3))) bf16x8*)(kp);      kf[1]=*(const __attribute__((address_space(3))) bf16x8*)(kp+512);
  kf[2]=*(const __attribute__((address_space(3))) bf16x8*)(kp+2048); kf[3]=*(const __attribute__((address_space(3))) bf16x8*)(kp+2560);
  kf[4]=*(const __attribute__((address_space(3))) bf16x8*)(kp+4096); kf[5]=*(const __attribute__((address_space(3))) bf16x8*)(kp+4608);
  kf[6]=*(const __attribute__((address_space(3))) bf16x8*)(kp+6144); kf[7]=*(const __attribute__((address_space(3))) bf16x8*)(kp+6656);
}
__device__ __forceinline__ void kload2(bf16x8*kf,lds_cptr kp,int j){ kf[2*j]=*(const __attribute__((address_space(3))) bf16x8*)(kp+j*2048); kf[2*j+1]=*(const __attribute__((address_space(3))) bf16x8*)(kp+j*2048+512); }
__device__ __forceinline__ s16x4 vtr(lds_cptr p){ return __builtin_bit_cast(s16x4,__builtin_amdgcn_ds_read_tr16_b64_v4i16((__attribute__((address_space(3))) v4i16_t*)p)); }
__device__ __forceinline__ float rowmax(const f32x16&p0,const f32x16&p1){
  float a=max3f(p0[0],p0[1],p1[0]),b=max3f(p0[2],p0[3],p1[1]);a=max3f(a,p1[2],p1[3]);
  #pragma unroll
  for(int r=4;r<16;r+=4){a=max3f(a,p0[r],p0[r+1]);b=max3f(b,p0[r+2],p0[r+3]);a=max3f(a,p1[r],p1[r+1]);b=max3f(b,p1[r+2],p1[r+3]);}
  const float m=max2f(a,b);
  auto rr=__builtin_amdgcn_permlane32_swap(__float_as_uint(m),__float_as_uint(m),false,false);
  return max2f(__uint_as_float(rr[0]),__uint_as_float(rr[1]));
}
__device__ __forceinline__ void pv(f32x16*o,int vb,bf16x8 pa0,bf16x8 pa1,bf16x8 pa2,bf16x8 pa3){
  #pragma unroll
  for(int d0=0;d0<2;++d0){s16x4 lo[4],hi[4];
    #pragma unroll
    for(int ks=0;ks<4;++ks){
      asm volatile("ds_read_b64_tr_b16 %0,%1 offset:%c2":"=&v"(lo[ks]):"v"(vb),"i"(d0*4096+ks*1024):"memory");
      asm volatile("ds_read_b64_tr_b16 %0,%1 offset:%c2":"=&v"(hi[ks]):"v"(vb),"i"(d0*4096+ks*1024+512):"memory");}
    asm volatile("s_waitcnt lgkmcnt(0)":::"memory");SBAR();
    #define PK(k) (bf16x8){lo[k][0],lo[k][1],lo[k][2],lo[k][3],hi[k][0],hi[k][1],hi[k][2],hi[k][3]}
    o[d0]=__builtin_amdgcn_mfma_f32_32x32x16_bf16(pa0,PK(0),o[d0],0,0,0);
    o[d0]=__builtin_amdgcn_mfma_f32_32x32x16_bf16(pa1,PK(1),o[d0],0,0,0);
    o[d0]=__builtin_amdgcn_mfma_f32_32x32x16_bf16(pa2,PK(2),o[d0],0,0,0);
    o[d0]=__builtin_amdgcn_mfma_f32_32x32x16_bf16(pa3,PK(3),o[d0],0,0,0);
    #undef PK
  }
}

__device__ __forceinline__ int attn_j0(int b,int h,int qb,const float*__restrict__ FB,const unsigned*__restrict__ QN2,const unsigned*__restrict__ KN2,int lane){
  const int q0=qb*QB; const float* FBs=FB+((long)b*NHEAD+h)*SEQ; const int NT0=(q0+QB)/KVBLK;
  const unsigned*qp_=QN2+((b*NHEAD+h)*NQB+qb)*2,*kp_=KN2+(b*NHEAD+h)*2;
  const float qn=sqrtf(__uint_as_float(qp_[0])+__uint_as_float(qp_[1])), kn=sqrtf(__uint_as_float(kp_[0])+__uint_as_float(kp_[1]));
  const float thr=2.0f*qn*kn*1.02f+40.0f, fq0=FBs[q0];
  const int ja=lane, jb2=lane+64;
  const bool sa=(ja<NT0)&&(fq0-FBs[ja*KVBLK+KVBLK-1]>thr), sb=(jb2<NT0)&&(fq0-FBs[jb2*KVBLK+KVBLK-1]>thr);
  int j0=__builtin_popcountll(__ballot(sa))+__builtin_popcountll(__ballot(sb)); j0&=~1; if(j0>NT0-4)j0=NT0-4; return j0;
}
#ifndef ATTN_STORE16
#define ATTN_STORE16(p,v) (*(u32x4*)(p)=(v))
#endif
template<int THRL> __device__ __forceinline__ void attn_unit(int b,int h,int qb,const bf16*Q,const bf16*__restrict__ K,const bf16*__restrict__ V,bf16*O,const float*__restrict__ FB,int j0_in,char*shm,
                                                             bool pre,bool has_next,int nb,int nh,int nqb,int nj0,bf16x8 (&qr)[4]){
  int tid=threadIdx.x; asm volatile("":"+v"(tid)); const int lane=tid&63,r32=lane&31,hi=lane>>5; const int wid=__builtin_amdgcn_readfirstlane(tid>>6);
  const long rowbase=(long)b*SEQ; const int q0=qb*QB;
  const bf16*Qw=Q+(rowbase+q0+wid*QBLK)*DM+h*D;
  const int j0=j0_in;
  const bf16*Kh=K+(rowbase+(long)j0*KVBLK)*DM+h*D,*Vh=V+(rowbase+(long)j0*KVBLK)*DM+h*D;
  const unsigned lds0=(unsigned)(uintptr_t)shm;
  float*wsf=(float*)(shm+LDS_WS)+wid*64;
  const bf16*ksrc=Kh+(long)lane*DM+wid*8;
  const bf16*vsrc=Vh+(long)(16*(wid&3)+(lane>>2))*DM+(wid>>2)*32+(lane&3)*8;
  const unsigned kdst=lds0+LDS_K+wid*1024, vdst=lds0+LDS_V+wid*1024;
  const float*fbsrc=FB+((long)b*NHEAD+h)*SEQ+(long)j0*KVBLK+lane; const unsigned fbdst=lds0+LDS_FB+wid*1024;
  #define DMA_K(t,slot) do{ glds16(ksrc+(long)(t)*KVBLK*DM,(unsigned)__builtin_amdgcn_readfirstlane(kdst+(slot))); glds4(fbsrc+(long)(t)*KVBLK,(unsigned)__builtin_amdgcn_readfirstlane(fbdst+(((t)&3)<<8))); }while(0)
  #define DMA_V(t,slot) glds16(vsrc+(long)(t)*KVBLK*DM,(unsigned)__builtin_amdgcn_readfirstlane(vdst+(slot)))
  const int vb0=(int)(lds0+LDS_V)+((lane>>4)&1)*32+(lane&3)*8+(4*hi+((lane&15)>>2))*64;
  const char*Kbase=shm+LDS_K; bf16x8 kf[8];
  const lds_cptr shm3=(lds_cptr)shm; const lds_cptr kp0=shm3+LDS_K+hi*1024+r32*16; const lds_cptr vp0=shm3+LDS_V+((lane>>4)&1)*32+(lane&3)*8+(4*hi+((lane&15)>>2))*64;
  const int NT=(q0+QB)/KVBLK-j0;
  if(!pre){ DMA_K(0,0);DMA_V(0,0);DMA_K(1,SLOTB); }
  if(!pre){
    #pragma unroll
    for(int d0=0;d0<4;++d0)qr[d0]=*reinterpret_cast<const bf16x8*>(&Qw[(long)r32*DM+d0*16+hi*8]); }
  float mhat=0.f,l_reg=0.f;f32x16 o[2];
  _Pragma("unroll") for(int d_=0;d_<2;++d_) _Pragma("unroll") for(int r=0;r<16;++r){ float z_; asm volatile("v_mov_b32 %0, 0":"=v"(z_)); o[d_][r]=z_; }
  const int qrel=wid*QBLK+r32;
  #define CMASK(P0,P1,t) do{int jb_=(t)-(NT-4); if(jb_>=0)cmask(P0,P1,jb_,qrel,hi);}while(0)
  const unsigned hmask=hi?0u:0xffffffffu, c3f=0x3F803F80u&hmask;
  u32x4 mqw; mqw[0]=c3f; mqw[1]=0x3F80u&hmask; mqw[2]=0u; mqw[3]=0u;
  const __attribute__((address_space(3))) float* fbw=(const __attribute__((address_space(3))) float*)(shm3+LDS_FB+wid*1024)+r32;
  #define SETMQ() do{ const float nm_=-mhat; const unsigned u1_=__float_as_uint(nm_)&0xffff0000u; const float q1_=nm_-__uint_as_float(u1_); const unsigned u2_=__float_as_uint(q1_)&0xffff0000u; \
      const float q2_=q1_-__uint_as_float(u2_); const unsigned u3_=__float_as_uint(q2_)&0xffff0000u; mqw[1]=(0x3F80u|u1_)&hmask; mqw[2]=((u2_>>16)|u3_)&hmask; }while(0)
  #define BFRAG(dst,bv) do{ const unsigned u1_=__float_as_uint(bv)&0xffff0000u; const float q1_=(bv)-__uint_as_float(u1_); const unsigned u2_=__float_as_uint(q1_)&0xffff0000u; \
      const float q2_=q1_-__uint_as_float(u2_); const unsigned u3_=__float_as_uint(q2_)>>16; dst[0]=((u1_>>16)|u2_)&hmask; dst[1]=(u3_|0x3F800000u)&hmask; dst[2]=c3f; dst[3]=0u; }while(0)
  #define KBIAS(P0,P1,t) do{ const float bq0_=fbw[(((t)&3)<<6)], bq1_=fbw[(((t)&3)<<6)+32]; u32x4 ba_; \
      BFRAG(ba_,bq0_); P0=__builtin_amdgcn_mfma_f32_32x32x16_bf16(__builtin_bit_cast(bf16x8,ba_),__builtin_bit_cast(bf16x8,mqw),P0,0,0,0); \
      BFRAG(ba_,bq1_); P1=__builtin_amdgcn_mfma_f32_32x32x16_bf16(__builtin_bit_cast(bf16x8,ba_),__builtin_bit_cast(bf16x8,mqw),P1,0,0,0); }while(0)
  bool resc=false;
  #define START(P0,P1) do{ const float rm=rowmax(P0,P1); resc=false; \
    { const float dl=rm; mhat=fadd_s(mhat,dl); \
      _Pragma("unroll") for(int r=0;r<16;++r){P0[r]=fsub_s(P0[r],dl);P1[r]=fsub_s(P1[r],dl);} \
      SETMQ(); } \
    _Pragma("unroll") for(int r=0;r<16;++r)P0[r]=__builtin_amdgcn_exp2f(P0[r]); }while(0)
  #define RESC() do{ if(resc){ asm volatile("s_waitcnt lgkmcnt(0)":::"memory"); \
      _Pragma("unroll") for(int d_=0;d_<2;++d_) _Pragma("unroll") for(int r=0;r<16;++r)o[d_][r]*=wsf[crow(r,hi)]; } }while(0)
  f32x16 pA0,pA1,pB0,pB1;
  int sl_prev=0,sl_cur=0,sl_next=SLOTB;
  #define ROT() do{sl_prev=sl_cur;sl_cur=sl_next;sl_next=(sl_next==(NSLOT-1)*SLOTB)?0:sl_next+SLOTB;}while(0)
  if(!pre){ DMA_K(2,2*SLOTB); }
  WAIT_BAR(5);
  qkt(pA0,pA1,Kbase,qr,r32,hi);KBIAS(pA0,pA1,0);asm volatile("s_nop 15\n\ts_nop 7":"+v"(pA0),"+v"(pA1));CMASK(pA0,pA1,0);
  START(pA0,pA1);
  _Pragma("unroll") for(int r=0;r<16;++r)pA1[r]=__builtin_amdgcn_exp2f(pA1[r]);
  WAIT_BAR(0);
  DMA_K(3,0);DMA_V(1,SLOTB);
  ROT();
  kload8(kf,kp0+sl_cur);
  WAIT_BAR(3);
  s16x4 vlo[8],vhi[8]; u32x4 pw0,pw1,pw2,pw3;
  #define PKW(P,B) cvtpk_s(P[B],P[B+1])
  #define PAF(k) __builtin_bit_cast(bf16x8,pw##k)
  #define VFR(i) (bf16x8){vlo[i][0],vlo[i][1],vlo[i][2],vlo[i][3],vhi[i][0],vhi[i][1],vhi[i][2],vhi[i][3]}
  #define PIN(x) asm volatile("":"+v"(x))
  #define MX3(a,b,c) __builtin_fmaxf(__builtin_fmaxf((a),(b)),(c))
  #define GAPA(MF,A0,A1,A2,A3,W0,W1,PW) do{ MF; sacc+=A0; sacc+=A1; sacc+=A2; sacc+=A3; PIN(sacc); W0; W1; PIN(PW); SBAR(); }while(0)
  #define EX(v) __builtin_amdgcn_exp2f(v)
  #define GAPB(MF,X,B) do{ MF; X[B]=EX(X[B]); X[B+1]=EX(X[B+1]); X[B+2]=EX(X[B+2]); X[B+3]=EX(X[B+3]); PIN(X); SBAR(); }while(0)
  #define VRD(i) do{ vlo[i]=vtr(vp_+(((i)>>2)*4096+((i)&3)*1024)); vhi[i]=vtr(vp_+(((i)>>2)*4096+((i)&3)*1024+512)); }while(0)
  #define KRD(G,j) do{ if(G){ kload2(kf,kp0+sl_next,j); SBAR(); } }while(0)
  #define STEP(C0,C1,P0,P1,t,GK,GV,GL) do{ SBAR(); \
    const lds_cptr vp_=vp0+sl_prev; \
    VRD(0); SBAR(); float sacc=(P0[0]+P0[1]); \
    GAPA(C0=__builtin_amdgcn_mfma_f32_32x32x16_bf16(kf[0],qr[0],f32x16{},0,0,0), P0[2],P0[3],P0[4],P0[5],     pw0[0]=PKW(P0,0), pw0[1]=PKW(P0,2), pw0); \
    VRD(4); SBAR(); GAPA(C1=__builtin_amdgcn_mfma_f32_32x32x16_bf16(kf[1],qr[0],f32x16{},0,0,0), P0[6],P0[7],P0[8],P0[9],     pw0[2]=PKW(P0,4), pw0[3]=PKW(P0,6), pw0); \
    VRD(1); SBAR(); GAPA(C0=__builtin_amdgcn_mfma_f32_32x32x16_bf16(kf[2],qr[1],C0,0,0,0),   P0[10],P0[11],P0[12],P0[13], pw1[0]=PKW(P0,8), pw1[1]=PKW(P0,10), pw1); \
    VRD(5); SBAR(); GAPA(C1=__builtin_amdgcn_mfma_f32_32x32x16_bf16(kf[3],qr[1],C1,0,0,0),   P0[14],P0[15],P1[0],P1[1],   pw1[2]=PKW(P0,12),pw1[3]=PKW(P0,14), pw1); \
    VRD(2); SBAR(); GAPA(C0=__builtin_amdgcn_mfma_f32_32x32x16_bf16(kf[4],qr[2],C0,0,0,0),   P1[2],P1[3],P1[4],P1[5],     pw2[0]=PKW(P1,0), pw2[1]=PKW(P1,2), pw2); \
    VRD(6); SBAR(); GAPA(C1=__builtin_amdgcn_mfma_f32_32x32x16_bf16(kf[5],qr[2],C1,0,0,0),   P1[6],P1[7],P1[8],P1[9],     pw2[2]=PKW(P1,4), pw2[3]=PKW(P1,6), pw2); \
    VRD(3); SBAR(); GAPA(C0=__builtin_amdgcn_mfma_f32_32x32x16_bf16(kf[6],qr[3],C0,0,0,0),   P1[10],P1[11],P1[12],P1[13], pw3[0]=PKW(P1,8), pw3[1]=PKW(P1,10), pw3); \
    VRD(7); SBAR(); GAPA(C1=__builtin_amdgcn_mfma_f32_32x32x16_bf16(kf[7],qr[3],C1,0,0,0),   P1[14],P1[15],0.f,0.f,       pw3[2]=PKW(P1,12),pw3[3]=PKW(P1,14), pw3); \
    KBIAS(C0,C1,t); SBAR(); l_reg+=sacc; \
    if(GK){DMA_K((t)+3,sl_cur);} if(GV){DMA_V((t)+1,sl_next);} \
    CMASK(C0,C1,t); \
    { float a=MX3(C0[0],C0[1],C1[0]),b=MX3(C0[2],C0[3],C1[1]); a=MX3(a,C1[2],C1[3]); \
      _Pragma("unroll") for(int r=4;r<16;r+=4){a=MX3(a,C0[r],C0[r+1]);b=MX3(b,C0[r+2],C0[r+3]);a=MX3(a,C1[r],C1[r+1]);b=MX3(b,C1[r+2],C1[r+3]);} \
      float rm=__builtin_fmaxf(a,b); { auto rr=__builtin_amdgcn_permlane32_swap(__float_as_uint(rm),__float_as_uint(rm),false,false); rm=__builtin_fmaxf(__uint_as_float(rr[0]),__uint_as_float(rr[1])); } \
      resc=false; \
      if(__builtin_expect(__any(rm>(float)THRL),0)){ const float dl=__builtin_fmaxf(rm,0.f); mhat+=dl; \
        _Pragma("unroll") for(int r=0;r<16;++r){C0[r]-=dl;C1[r]-=dl;} \
        SETMQ(); \
        const float f=__builtin_amdgcn_exp2f(-dl); l_reg*=f; if(hi==0)wsf[r32]=f; resc=true; } } \
    SBAR(); \
    GAPB(o[0]=__builtin_amdgcn_mfma_f32_32x32x16_bf16(PAF(0),VFR(0),o[0],0,0,0), C0,0); \
    GAPB(o[1]=__builtin_amdgcn_mfma_f32_32x32x16_bf16(PAF(0),VFR(4),o[1],0,0,0), C0,4); \
    KRD(GL,0); GAPB(o[0]=__builtin_amdgcn_mfma_f32_32x32x16_bf16(PAF(1),VFR(1),o[0],0,0,0), C0,8); \
    KRD(GL,1); GAPB(o[1]=__builtin_amdgcn_mfma_f32_32x32x16_bf16(PAF(1),VFR(5),o[1],0,0,0), C0,12); \
    KRD(GL,2); GAPB(o[0]=__builtin_amdgcn_mfma_f32_32x32x16_bf16(PAF(2),VFR(2),o[0],0,0,0), C1,0); \
    KRD(GL,3); GAPB(o[1]=__builtin_amdgcn_mfma_f32_32x32x16_bf16(PAF(2),VFR(6),o[1],0,0,0), C1,4); \
    GAPB(o[0]=__builtin_amdgcn_mfma_f32_32x32x16_bf16(PAF(3),VFR(3),o[0],0,0,0), C1,8); \
    GAPB(o[1]=__builtin_amdgcn_mfma_f32_32x32x16_bf16(PAF(3),VFR(7),o[1],0,0,0), C1,12); \
    }while(0)
  int t=1;
  #undef CMASK
  #define CMASK(P0,P1,t) do{}while(0)
  for(;t+5<NT;t+=2){
    STEP(pB0,pB1,pA0,pA1,t,true,true,true);     WAIT_BAR(3); RESC(); ROT();
    STEP(pA0,pA1,pB0,pB1,t+1,true,true,true);   WAIT_BAR(3); RESC(); ROT();
  }
  #undef CMASK
  #define CMASK(P0,P1,t) do{int jb_=(t)-(NT-4); if(jb_>=0)cmask(P0,P1,jb_,qrel,hi);}while(0)
  #define ENDW(tt) do{ if((tt)+3<NT){WAIT_BAR(3);} else if((tt)+2<NT){WAIT_BAR(1);} else {WAIT_BAR(0);} }while(0)
  for(;t+1<NT;t+=2){
    STEP(pB0,pB1,pA0,pA1,t,(t+3<NT),(t+1<NT),(t+1<NT));       ENDW(t);   RESC(); ROT();
    STEP(pA0,pA1,pB0,pB1,t+1,(t+4<NT),(t+2<NT),(t+2<NT));     ENDW(t+1); RESC(); ROT();
  }
  STEP(pB0,pB1,pA0,pA1,NT-1,false,false,false); RESC();
  { float sacc=pB0[0]+pB0[1]; _Pragma("unroll") for(int r=2;r<16;++r)sacc+=pB0[r]; _Pragma("unroll") for(int r=0;r<16;++r)sacc+=pB1[r]; l_reg+=sacc;
    pw0=(u32x4){PKW(pB0,0),PKW(pB0,2),PKW(pB0,4),PKW(pB0,6)};pw1=(u32x4){PKW(pB0,8),PKW(pB0,10),PKW(pB0,12),PKW(pB0,14)};pw2=(u32x4){PKW(pB1,0),PKW(pB1,2),PKW(pB1,4),PKW(pB1,6)};pw3=(u32x4){PKW(pB1,8),PKW(pB1,10),PKW(pB1,12),PKW(pB1,14)};
    SBAR(); pv(o,vb0+sl_cur,PAF(0),PAF(1),PAF(2),PAF(3)); }
  #undef PKW
  #undef PAF
  #undef VFR
  #undef PIN
  #undef MX3
  #undef GAPA
  #undef GAPB
  #undef EX
  #undef VRD
  #undef KRD
  #undef STEP
  #undef ENDW
  asm volatile("s_waitcnt lgkmcnt(0)\n\ts_barrier":::"memory");
  if(has_next){
    const long nrowbase=(long)nb*SEQ; const int nq0=nqb*QB;
    const bf16*nKh=K+(nrowbase+(long)nj0*KVBLK)*DM+nh*D,*nVh=V+(nrowbase+(long)nj0*KVBLK)*DM+nh*D;
    const bf16*nks=nKh+(long)lane*DM+wid*8; const bf16*nvs=nVh+(long)(16*(wid&3)+(lane>>2))*DM+(wid>>2)*32+(lane&3)*8;
    const float*nfb=FB+((long)nb*NHEAD+nh)*SEQ+(long)nj0*KVBLK+lane;
    #define NDMA_K(t,slot) do{ glds16(nks+(long)(t)*KVBLK*DM,(unsigned)__builtin_amdgcn_readfirstlane(kdst+(slot))); glds4(nfb+(long)(t)*KVBLK,(unsigned)__builtin_amdgcn_readfirstlane(fbdst+(((t)&3)<<8))); }while(0)
    NDMA_K(0,0); glds16(nvs,(unsigned)__builtin_amdgcn_readfirstlane(vdst)); NDMA_K(1,SLOTB); NDMA_K(2,2*SLOTB);
    #undef NDMA_K
    const bf16*nQw=Q+(nrowbase+nq0+wid*QBLK)*DM+nh*D;
    #pragma unroll
    for(int d0=0;d0<4;++d0)qr[d0]=*reinterpret_cast<const bf16x8*>(&nQw[(long)r32*DM+d0*16+hi*8]);
  }
  {auto rr=__builtin_amdgcn_permlane32_swap(__float_as_uint(l_reg),__float_as_uint(l_reg),false,false);l_reg=__uint_as_float(rr[0])+__uint_as_float(rr[1]);}
  if(hi==0)wsf[32+r32]=l_reg;asm volatile("s_waitcnt lgkmcnt(0)":::"memory");
  float rli[16];
  #pragma unroll
  for(int r=0;r<16;++r)rli[r]=__builtin_amdgcn_rcpf(wsf[32+crow(r,hi)]);
  unsigned char*Ow=(unsigned char*)O+(rowbase+q0+wid*QBLK)*DM+h*D;
  { unsigned char*stg=(unsigned char*)(shm+LDS_OST)+wid*4096;
    #pragma unroll
    for(int r=0;r<16;++r){const int orow=crow(r,hi); const float sc_=rli[r]*O_SCALE;
      #pragma unroll
      for(int d0=0;d0<2;++d0){ const float x_=__builtin_amdgcn_fmed3f(o[d0][r]*sc_,-448.0f,448.0f); int w_; asm volatile("v_mov_b32 %0, 0":"=v"(w_)); w_=__builtin_amdgcn_cvt_pk_fp8_f32(x_,x_,w_,false); stg[orow*64+d0*32+r32]=(unsigned char)w_; } }
    asm volatile("s_waitcnt lgkmcnt(0)":::"memory");
    #pragma unroll
    for(int i=0;i<2;++i){const int row=i*16+(lane>>2),ch=lane&3; const u32x4 v=*(const u32x4*)(stg+row*64+ch*16); ATTN_STORE16(Ow+(long)row*DM+ch*16,v);} }
  asm volatile("s_waitcnt lgkmcnt(0)":::"memory");
  #undef DMA_K
  #undef DMA_V
  #undef KBIAS
  #undef BFRAG
  #undef SETMQ
  #undef CMASK
  #undef START
  #undef RESC
  #undef ROT
}
constexpr int ATTN_LDS_BYTES=LDS_BYTES;
struct AttnTensors { const bf16* Q; const bf16* K; const bf16* V; bf16* O; const float* FB; const unsigned* QN2; const unsigned* KN2; };
struct AttnUnit { int bh; int qb; };
struct StaticOrder {
  int vcu;
  __device__ __forceinline__ explicit StaticOrder(int grid,int block):vcu((block%8)*(grid/8)+block/8){}
  __device__ __forceinline__ bool next(int i,AttnUnit&u)const{ if(i>=8)return false; const int x=vcu>>5,j=vcu&31; u.bh=8*x+i; u.qb=(j+4*i)&31; return true; }
  __device__ __forceinline__ void a_ready(const AttnUnit&)const{}
  __device__ __forceinline__ void done(const AttnUnit&)const{}
};
template<class Sched,int THRL=8> __device__ __forceinline__ void attn_phase(char*lds,const AttnTensors&T,const Sched&S,volatile __attribute__((address_space(3))) int*j0buf){
  AttnUnit u;
  { int tid=threadIdx.x; asm volatile("":"+v"(tid)); const int lane=tid&63,wid=__builtin_amdgcn_readfirstlane(tid>>6);
    if(S.next(wid,u)){ const int j=attn_j0(u.bh/NHEAD,u.bh%NHEAD,u.qb,T.FB,T.QN2,T.KN2,lane); if(lane==0)j0buf[wid]=j; }
    asm volatile("s_waitcnt lgkmcnt(0)\n\ts_barrier":::"memory"); }
  bf16x8 qr[4]; bool pre=false;
  #pragma unroll 1
  for(int i=0;S.next(i,u);++i){ S.a_ready(u); AttnUnit un; const bool hn=S.next(i+1,un); const int nj0=hn?__builtin_amdgcn_readfirstlane(j0buf[i+1]):0;
    attn_unit<THRL>(u.bh/NHEAD,u.bh%NHEAD,u.qb,T.Q,T.K,T.V,T.O,T.FB,__builtin_amdgcn_readfirstlane(j0buf[i]),lds,pre,hn,un.bh/NHEAD,un.bh%NHEAD,un.qb,nj0,qr); pre=hn; S.done(u); }
}
#undef SBAR
#undef WAIT_BAR
}
constexpr int NWAVES = 8;
constexpr size_t MiB = 1u << 20;
constexpr size_t WS_CTL = 0, CTL_ZERO_BYTES = 1 * MiB;
constexpr size_t WS_MODV = 1 * MiB;
constexpr size_t WS_R1 = 2 * MiB;
constexpr size_t WS_LF = 3 * MiB, WS_FB = 5 * MiB;
constexpr size_t WS_SLOTP = 8 * MiB, WS_SLOTG = 12 * MiB;
constexpr size_t WS_WPOOL = 16 * MiB, WS_WO = 18 * MiB, WS_WQKV = 22 * MiB;
constexpr size_t WS_HB = 64 * MiB;
constexpr size_t WS_Q = 128 * MiB, WS_K = 192 * MiB, WS_V = 256 * MiB;
constexpr size_t WS_YS = 320 * MiB;
constexpr size_t WS_ACT = 576 * MiB;
constexpr size_t WS_W2 = 848 * MiB, WS_W1 = 1104 * MiB;
constexpr size_t WS_XB = 1616 * MiB, WS_END = 1680 * MiB;
static_assert(WS_ACT + (size_t)MAXMT * 256 * 1024 * 2 <= WS_W2 && WS_W1 + (size_t)DEPTH * NEXP * 2048 * 1024 * 2 <= WS_XB && WS_XB + (size_t)T * D * 2 <= WS_END, "d_ws map");
constexpr int CW_TMO = 0, CW_CODE = 1, CW_BAR = 4096, CW_GCNT = 8192, CW_KN2 = 8448, CW_QN2 = 8704;
constexpr int RING_OFF = 0, RING_BYTES = 131072;
constexpr int IDX_OFF = RING_BYTES;
constexpr int SCHED_OFF = IDX_OFF + pg8::IDX_BYTES;
constexpr int MISC_OFF = SCHED_OFF + 1024;
constexpr int LDS_BYTES = 147456;
static_assert(MISC_OFF + 128 <= LDS_BYTES, "LDS map");

typedef unsigned short bf16;
typedef unsigned v4u __attribute__((ext_vector_type(4)));
typedef unsigned v2u __attribute__((ext_vector_type(2)));
typedef float f32x4 __attribute__((ext_vector_type(4)));
typedef GAS unsigned gu32;
#define RLX_AGENT __ATOMIC_RELAXED, __HIP_MEMORY_SCOPE_AGENT
#define LDS_WAIT() asm volatile("s_waitcnt lgkmcnt(0)" ::: "memory")
#define VM_WAIT() asm volatile("s_waitcnt vmcnt(0)" ::: "memory")
__device__ __forceinline__ unsigned f2bf(float f) { unsigned u = __builtin_bit_cast(unsigned, f); return (u + 0x7fffu + ((u >> 16) & 1u)) >> 16; }
__device__ __forceinline__ unsigned pk2(float lo, float hi) { return f2bf(lo) | (f2bf(hi) << 16); }
__device__ __forceinline__ float bflo(unsigned u) { return __builtin_bit_cast(float, u << 16); }
__device__ __forceinline__ float bfhi(unsigned u) { return __builtin_bit_cast(float, u & 0xffff0000u); }
template <bool BF> __device__ __forceinline__ f32x4 ldx4(const void* base, size_t eoff) {
    if (BF) { const v2u w = *(const GAS v2u*)((const bf16*)base + eoff); return (f32x4){bflo(w.x), bfhi(w.x), bflo(w.y), bfhi(w.y)}; }
    return *(const GAS f32x4*)((const float*)base + eoff);
}
__device__ __forceinline__ void stx4_bf(bf16* base, size_t eoff, f32x4 v) { v2u o; o.x = pk2(v.x, v.y); o.y = pk2(v.z, v.w); *(GAS v2u*)(base + eoff) = o; }
#define XB_TMO      128
#define XB_XCNT(j)  (256  + 64 * (j))
#define XB_XSUB(j)  (1280 + 64 * (j))
#define XB_XGEN(j)  (2304 + 64 * (j))
#define XB_TOP      3328
#define XB_TOPGEN   3392
#define XCD_BAR_WORDS 3456
#define XB_SPIN_CAP (1u << 18)

__device__ __forceinline__ unsigned xb_ld(unsigned* p)              { return __hip_atomic_load(p, __ATOMIC_RELAXED, __HIP_MEMORY_SCOPE_AGENT); }
__device__ __forceinline__ unsigned xb_add(unsigned* p, unsigned v) { return __hip_atomic_fetch_add(p, v, __ATOMIC_RELAXED, __HIP_MEMORY_SCOPE_AGENT); }
__device__ __forceinline__ unsigned xb_xcc_id() { return (unsigned)__builtin_amdgcn_s_getreg((3 << 11) | 20) & 0xFu; }
#define XB_SPIN(cond, bar) do { unsigned _sp = 0; while (cond) { __builtin_amdgcn_s_sleep(1); \
    if ((++_sp & 255u) == 0u) { if (xb_ld(&(bar)[XB_TMO])) break; if (_sp > XB_SPIN_CAP) { atomicAdd(&(bar)[XB_TMO], 1u); break; } } } } while (0)

struct XcdBarrier {
    unsigned* bar; unsigned x;
    volatile LAS unsigned* st;
};

__device__ __forceinline__ XcdBarrier xcd_barrier_post(unsigned* bar, volatile LAS unsigned* st) {
    XcdBarrier b; b.bar = bar; b.x = xb_xcc_id(); b.st = st;
    if (threadIdx.x == 0) (void)xb_add(&bar[XB_XCNT(b.x)], 1u);
    return b;
}
__device__ __forceinline__ void xcd_barrier_complete(unsigned* bar, unsigned x, unsigned& nloc, unsigned& nx) {
    const unsigned G = gridDim.x * gridDim.y * gridDim.z;
    unsigned sum, cnt, mine, sp = 0u;
    for (;;) {
        sum = 0u; cnt = 0u; mine = 0u;
#pragma unroll
        for (unsigned j = 0; j < 16; ++j) { const unsigned c = xb_ld(&bar[XB_XCNT(j)]); sum += c; cnt += (c > 0u) ? 1u : 0u; mine = (j == x) ? c : mine; }
        if (sum == G) break;
        __builtin_amdgcn_s_sleep(1);
        if ((++sp & 255u) == 0u) { if (xb_ld(&bar[XB_TMO])) break; if (sp > XB_SPIN_CAP) { atomicAdd(&bar[XB_TMO], 1u); break; } }
    }
    nloc = mine > 0u ? mine : 1u; nx = cnt > 0u ? cnt : 1u;
}

__device__ __forceinline__ void xcd_barrier(const XcdBarrier& b) {
    asm volatile("s_waitcnt vmcnt(0)" ::: "memory");
    __syncthreads();
    if (threadIdx.x == 0) {
        unsigned* bar = b.bar;
        __builtin_amdgcn_s_waitcnt(0);
        unsigned nloc = b.st[0], nx = b.st[1];
        if (nloc == 0u) { xcd_barrier_complete(bar, b.x, nloc, nx); b.st[0] = nloc; b.st[1] = nx; }
        const unsigned old = xb_add(&bar[XB_XSUB(b.x)], 1u);
        const unsigned gen = old / nloc;
        if (old + 1u == (gen + 1u) * nloc) {
            __builtin_amdgcn_fence(__ATOMIC_RELEASE, "agent");
            asm volatile("s_waitcnt vmcnt(0)" ::: "memory");
            const unsigned og = xb_add(&bar[XB_TOP], 1u);
            const unsigned tg = og / nx;
            if (og + 1u == (tg + 1u) * nx) xb_add(&bar[XB_TOPGEN], 1u);
            else XB_SPIN(xb_ld(&bar[XB_TOPGEN]) == tg, bar);
            __builtin_amdgcn_fence(__ATOMIC_ACQUIRE, "agent");
            xb_add(&bar[XB_XGEN(b.x)], 1u);
            asm volatile("s_waitcnt vmcnt(0)" ::: "memory");
        } else {
            XB_SPIN(xb_ld(&bar[XB_XGEN(b.x)]) == gen, bar);
            __builtin_amdgcn_fence(__ATOMIC_ACQUIRE, "agent");
            asm volatile("s_waitcnt vmcnt(0)" ::: "memory");
        }
    }
    __syncthreads();
}
struct Frame {
    LAS unsigned char* lds;
    volatile LAS unsigned* MISC;
    gu32* ctl;
    int tid, lane, wave, G, bid;
};
template <int CTRL, int ROWMASK = 0xF> __device__ __forceinline__ float dppf(float v) { return __builtin_bit_cast(float, __builtin_amdgcn_update_dpp(0, __builtin_bit_cast(int, v), CTRL, ROWMASK, 0xF, false)); }
__device__ __forceinline__ float wave_sum(float v) {
    v += dppf<0xB1>(v); v += dppf<0x4E>(v); v += dppf<0x141>(v); v += dppf<0x140>(v);
    { const auto r = __builtin_amdgcn_permlane16_swap(__float_as_uint(v), __float_as_uint(v), false, false); v = __uint_as_float(r[0]) + __uint_as_float(r[1]); }
    { const auto r = __builtin_amdgcn_permlane32_swap(__float_as_uint(v), __float_as_uint(v), false, false); v = __uint_as_float(r[0]) + __uint_as_float(r[1]); }
    return v;
}
__device__ __forceinline__ float wave_incl_scan(float x) {
    x += dppf<0x111>(x); x += dppf<0x112>(x); x += dppf<0x114>(x); x += dppf<0x118>(x);
    x += dppf<0x142, 0xA>(x);
    x += dppf<0x143, 0xC>(x);
    return x;
}

__device__ __forceinline__ void transpose_item(const float* src, int src_ld, bf16* dst, int dst_ld, int k0, int ns0, int nd0, LAS float* scr, int lane) {
    f32x4 v[8];
#pragma unroll
    for (int it = 0; it < 8; ++it) { const int kk = (lane >> 3) + 8 * it; v[it] = *(const GAS f32x4*)(src + (size_t)(k0 + kk) * src_ld + ns0 + (lane & 7) * 4); }
#pragma unroll
    for (int it = 0; it < 8; ++it) { const int kk = (lane >> 3) + 8 * it; LAS float* s = scr + kk * 33 + (lane & 7) * 4; s[0] = v[it].x; s[1] = v[it].y; s[2] = v[it].z; s[3] = v[it].w; }
    LDS_WAIT(); asm volatile("" ::: "memory");
    const int c = lane & 7;
#pragma unroll
    for (int j = 0; j < 4; ++j) { const int n = (lane >> 3) + 8 * j; const LAS float* s = scr + (8 * c) * 33 + n;
        v4u o; o.x = pk2(s[0 * 33], s[1 * 33]); o.y = pk2(s[2 * 33], s[3 * 33]); o.z = pk2(s[4 * 33], s[5 * 33]); o.w = pk2(s[6 * 33], s[7 * 33]);
        *(GAS v4u*)(dst + (size_t)(nd0 + n) * dst_ld + k0 + 8 * c) = o; }
    LDS_WAIT(); asm volatile("" ::: "memory");
}
__device__ __forceinline__ void transpose_item8(const float* src, int src_ld, unsigned char* dst, int dst_ld, int k0, int ns0, int nd0, LAS float* scr, int lane, float scale) {
    f32x4 v[16];
#pragma unroll
    for (int it = 0; it < 16; ++it) { const int kk = (lane >> 3) + 8 * it; v[it] = __builtin_nontemporal_load((const GAS f32x4*)(src + (size_t)(k0 + kk) * src_ld + ns0 + (lane & 7) * 4)); }
#pragma unroll
    for (int it = 0; it < 16; ++it) { const int kk = (lane >> 3) + 8 * it; LAS float* s = scr + kk * 33 + ((((lane & 7) + (kk >> 4)) * 4) & 31);
        s[0] = v[it].x * scale; s[1] = v[it].y * scale; s[2] = v[it].z * scale; s[3] = v[it].w * scale; }
    LDS_WAIT(); asm volatile("" ::: "memory");
    const int c = lane & 7;
#pragma unroll
    for (int j = 0; j < 4; ++j) { const int n = (lane >> 3) + 8 * j; const LAS float* s = scr + (16 * c) * 33 + ((n + 4 * c) & 31);
        v4u o; o.x = pg8::pk4_fp8(s[0 * 33], s[1 * 33], s[2 * 33], s[3 * 33]); o.y = pg8::pk4_fp8(s[4 * 33], s[5 * 33], s[6 * 33], s[7 * 33]);
        o.z = pg8::pk4_fp8(s[8 * 33], s[9 * 33], s[10 * 33], s[11 * 33]); o.w = pg8::pk4_fp8(s[12 * 33], s[13 * 33], s[14 * 33], s[15 * 33]);
        *(GAS v4u*)(dst + (size_t)(nd0 + n) * dst_ld + k0 + 16 * c) = o; }
    LDS_WAIT(); asm volatile("" ::: "memory");
}
struct ProIn { const float *c, *gmix, *gffn, *ada_w, *ada_b, *pool_w, *pool_scale, *fox_w_in, *fox_w_o, *exp_w_in, *exp_w_out; };
__device__ __forceinline__ void p0_prologue(Frame& F0, const ProIn& P, unsigned char* ws) {
    Frame F = F0; { int t_ = F0.tid; asm volatile("" : "+v"(t_)); F.tid = t_; F.lane = t_ & 63; F.wave = __builtin_amdgcn_readfirstlane(t_ >> 6); }
    LAS float* sc = (LAS float*)(F.lds + RING_OFF);
    LAS float* red = (LAS float*)(F.lds + RING_OFF + 16384);
    for (int i = F.tid; i < BATCH * D; i += NWAVES * 64) { const float v = P.c[i]; sc[i] = v / (1.0f + __expf(-v)); }
    __syncthreads();
    float* MODV = (float*)(ws + WS_MODV);
    for (int it = F.bid; it < DEPTH * 48; it += F.G) {
        const int L = it / 48, n0 = (it % 48) * 128;
        const float* wp = P.ada_w + ((size_t)L * D + 128 * F.wave) * (6 * D) + n0 + 2 * F.lane;
        float a00 = 0.f, a01 = 0.f, a10 = 0.f, a11 = 0.f, a20 = 0.f, a21 = 0.f, a30 = 0.f, a31 = 0.f;
#pragma unroll 16
        for (int k = 0; k < 128; ++k) { const pg8::f32x2 wv = *(const GAS pg8::f32x2*)(wp + (size_t)k * (6 * D)); const int kk = 128 * F.wave + k;
            const float s0 = sc[kk], s1 = sc[D + kk], s2 = sc[2 * D + kk], s3 = sc[3 * D + kk];
            a00 += s0 * wv.x; a01 += s0 * wv.y; a10 += s1 * wv.x; a11 += s1 * wv.y; a20 += s2 * wv.x; a21 += s2 * wv.y; a30 += s3 * wv.x; a31 += s3 * wv.y; }
        { LAS pg8::f32x2* rp = (LAS pg8::f32x2*)(red + (F.wave * 4) * 128) + F.lane;
          rp[0] = (pg8::f32x2){a00, a01}; rp[64] = (pg8::f32x2){a10, a11}; rp[128] = (pg8::f32x2){a20, a21}; rp[192] = (pg8::f32x2){a30, a31}; }
        __syncthreads();
        { const int b = F.tid >> 7, ln = F.tid & 127, nn = n0 + ln; float m = P.ada_b[L * 6 * D + nn];
#pragma unroll
            for (int w = 0; w < 8; ++w) m += red[(w * 4 + b) * 128 + ln];
            const int j = nn >> 10, cc = nn & 1023;
            if (j == 1) m = P.gmix[L * D + cc] * (1.0f + m);
            else if (j == 2) { if (!(L & 1)) m *= P.pool_scale[(L >> 1) * D + cc]; }
            else if (j == 4) m = P.gffn[L * D + cc] * (1.0f + m);
            MODV[((size_t)(L * BATCH + b) * 6 + j) * D + cc] = m; }
        __syncthreads();
    }
    LAS float* scr = (LAS float*)(F.lds + RING_OFF + F.wave * 16896);
    const int gw = F.bid * NWAVES + F.wave, NGW = F.G * NWAVES;
    static_assert(8 * 16896 <= MISC_OFF, "prologue scratch vs LDS map");
    constexpr int I_W1 = DEPTH * NEXP * 512, I_W2 = DEPTH * NEXP * 256, I_QKV = 2 * 768, I_WO = 2 * 256, I_PL = 8 * 32;
    for (int it = gw; it < I_W1 + I_W2 + I_QKV + I_WO + I_PL; it += NGW) {
        int r = it;
        if (r < I_W1) { const int m = r >> 9, q = r & 511, kb = q >> 6, nb = q & 63, nd0 = 32 * nb, pn = nd0 >> 8, j = nd0 & 255;
            const int ns0 = (j < 128) ? (128 * pn + j) : (FF + 128 * pn + (j - 128));
            transpose_item8(P.exp_w_in + (size_t)m * D * 2 * FF, 2 * FF, (unsigned char*)(ws + WS_W1) + (size_t)m * 2 * FF * D, D, 128 * kb, ns0, nd0, scr, F.lane, pg8::FP8_SW); continue; }
        r -= I_W1;
        if (r < I_W2) { const int m = r >> 8, q = r & 255, kb = q >> 5, nb = q & 31;
            transpose_item8(P.exp_w_out + (size_t)m * FF * D, D, (unsigned char*)(ws + WS_W2) + (size_t)m * D * FF, FF, 128 * kb, 32 * nb, 32 * nb, scr, F.lane, pg8::FP8_SW); continue; }
        r -= I_W2;
        if (r < I_QKV) { const int m = r / 768, q = r % 768, kb = q / 96, nb = q % 96;
            transpose_item8(P.fox_w_in + (size_t)m * D * FOX_LD, FOX_LD, (unsigned char*)(ws + WS_WQKV) + (size_t)m * NQKV * D, D, 128 * kb, 32 * nb, 32 * nb, scr, F.lane, pg8::FP8_SW); continue; }
        r -= I_QKV;
        if (r < I_WO) { const int m = r >> 8, q = r & 255, kb = q >> 5, nb = q & 31;
            transpose_item8(P.fox_w_o + (size_t)m * D * D, D, (unsigned char*)(ws + WS_WO) + (size_t)m * D * D, D, 128 * kb, 32 * nb, 32 * nb, scr, F.lane, pg8::FP8_SW); continue; }
        r -= I_WO;
        { const int m = r >> 5, q = r & 31, kb = q >> 3, nb = q & 7;
            transpose_item(P.pool_w + (size_t)m * 65536, 256, (bf16*)(ws + WS_WPOOL) + (size_t)m * 65536, 256, 64 * kb, 32 * nb, 32 * nb, scr, F.lane); }
    }
}

__device__ __forceinline__ f32x4 fp8x4_f32(unsigned w) { typedef float f2 __attribute__((ext_vector_type(2))); const f2 lo = __builtin_amdgcn_cvt_pk_f32_fp8((int)w, false), hi = __builtin_amdgcn_cvt_pk_f32_fp8((int)w, true); return (f32x4){lo.x, lo.y, hi.x, hi.y}; }
__device__ __forceinline__ f32x4 ys_sum4(unsigned a, unsigned b, unsigned c, unsigned d) { return (fp8x4_f32(a) + fp8x4_f32(b)) + (fp8x4_f32(c) + fp8x4_f32(d)); }
template <bool BF> struct XRaw { typedef f32x4 T; };
template <> struct XRaw<true> { typedef v2u T; };
template <bool BF> __device__ __forceinline__ typename XRaw<BF>::T ldxraw(const void* base, size_t eoff) {
    if constexpr (BF) return *(const GAS v2u*)((const bf16*)base + eoff); else return *(const GAS f32x4*)((const float*)base + eoff);
}
__device__ __forceinline__ f32x4 xraw_f32(v2u w) { return (f32x4){bflo(w.x), bfhi(w.x), bflo(w.y), bfhi(w.y)}; }
__device__ __forceinline__ f32x4 xraw_f32(f32x4 w) { return w; }
template <int MODE, bool SRCBF>
__device__ __forceinline__ void rows_phase(Frame& F0, bool combine, const void* xsrc, void* xdst, const unsigned char* ys, const float* g2v, float* r1out, const float* fg) {
    Frame F = F0; { int t_ = F0.tid; asm volatile("" : "+v"(t_)); F.tid = t_; F.lane = t_ & 63; F.wave = __builtin_amdgcn_readfirstlane(t_ >> 6); }
    typedef typename XRaw<SRCBF>::T XT;
    const int gw = F.bid * NWAVES + F.wave, NGW = F.G * NWAVES, per = (T + NGW - 1) / NGW, r0 = gw * per, r1 = (r0 + per < T) ? r0 + per : T;
    if (r0 >= r1) return;
    XT xn[4]; unsigned yn[4][4];
#define RP_LOAD(rw) do { _Pragma("unroll") for (int j_ = 0; j_ < 4; ++j_) xn[j_] = ldxraw<SRCBF>(xsrc, (size_t)(rw) * D + 4 * F.lane + 256 * j_); \
        if (combine) { _Pragma("unroll") for (int k_ = 0; k_ < 4; ++k_) { _Pragma("unroll") for (int j_ = 0; j_ < 4; ++j_) yn[k_][j_] = *((const GAS unsigned*)(ys + ((size_t)(rw) * 4 + k_) * D) + F.lane + 64 * j_); } } } while (0)
    RP_LOAD(r0);
    f32x4 fgv[4], g2r[4]; int bcur = -1;
    if (MODE == 1) {
#pragma unroll
        for (int j = 0; j < 4; ++j) fgv[j] = *((const GAS f32x4*)fg + F.lane + 64 * j); }
#pragma unroll 1
    for (int row = r0; row < r1; ++row) {
        const int b = row >> 13;
        XT xc[4]; unsigned yc[4][4];
#pragma unroll
        for (int j = 0; j < 4; ++j) { xc[j] = xn[j];
#pragma unroll
            for (int k = 0; k < 4; ++k) yc[k][j] = yn[k][j]; }
        if (combine && b != bcur) {
#pragma unroll
            for (int j = 0; j < 4; ++j) g2r[j] = *((const GAS f32x4*)(g2v + (size_t)b * 6 * D) + F.lane + 64 * j) * (1.0f / pg8::YS_SCALE);
            bcur = b; }
        if (row + 1 < r1) RP_LOAD(row + 1);
        f32x4 v[4];
#pragma unroll
        for (int j = 0; j < 4; ++j) v[j] = xraw_f32(xc[j]);
        if (combine) {
#pragma unroll
            for (int j = 0; j < 4; ++j) v[j] = v[j] + g2r[j] * ys_sum4(yc[0][j], yc[1][j], yc[2][j], yc[3][j]);
        }
        float ss = 0.f;
#pragma unroll
        for (int j = 0; j < 4; ++j) ss += (v[j].x * v[j].x + v[j].y * v[j].y) + (v[j].z * v[j].z + v[j].w * v[j].w);
        const float r = 1.0f / sqrtf(wave_sum(ss) * (1.0f / D) + EPS);
        if (MODE == 0) {
            if (combine) {
#pragma unroll
                for (int j = 0; j < 4; ++j) stx4_bf((bf16*)xdst, (size_t)row * D + 4 * F.lane + 256 * j, v[j]); }
            if (F.lane == 0) r1out[row] = r;
        } else {
            GAS f32x4* xo = (GAS f32x4*)((float*)xdst + (size_t)row * D) + F.lane;
#pragma unroll
            for (int j = 0; j < 4; ++j) xo[64 * j] = v[j] * r * fgv[j];
        }
    }
#undef RP_LOAD
}

template <bool SRCBF>
__device__ __forceinline__ void pool_d_phase(Frame& F0, const void* xsrc, const float* r1, const float* G1v, bf16* dout) {
    Frame F = F0; { int t_ = F0.tid; asm volatile("" : "+v"(t_)); F.tid = t_; F.lane = t_ & 63; F.wave = __builtin_amdgcn_readfirstlane(t_ >> 6); }
    typedef typename XRaw<SRCBF>::T XT;
    const int half = F.tid >> 8, cq = F.tid & 255, c0 = 4 * cq, w = __builtin_amdgcn_readfirstlane(2 << (cq >> 6));
    LAS f32x4* ring = (LAS f32x4*)(F.lds + RING_OFF) + F.tid;
    static_assert(16 * NWAVES * 64 * 16 <= RING_BYTES, "pool ring");
    for (int tile = F.bid; tile < T / 64; tile += F.G) {
        const int t0 = tile * 64 + 32 * half, b = t0 >> 13, tl0 = t0 & (SEQ - 1);
        const f32x4 Gc = *(const GAS f32x4*)(G1v + (size_t)b * 6 * D + c0);
        const size_t xb = (size_t)t0 * D + c0;
        const int kfirst = (-(w - 1) > -tl0) ? -(w - 1) : -tl0;
        f32x4 s = pg8::zero4();
        XT XA[8], XB[8]; float RA[8], RB[8];
#define PD_LOAD(XQ, RQ, kc) do { if ((kc) + 7 >= kfirst) { _Pragma("unroll") for (int j_ = 0; j_ < 8; ++j_) { const int k_ = (kc) + j_; if (k_ >= kfirst) { \
            XQ[j_] = ldxraw<SRCBF>(xsrc, (size_t)((long)xb + (long)k_ * D)); RQ[j_] = r1[t0 + k_]; } } } } while (0)
#define PD_PROC(XQ, RQ, kc) do { if ((kc) + 7 >= kfirst) { _Pragma("unroll") for (int j_ = 0; j_ < 8; ++j_) { const int k_ = (kc) + j_; if (k_ >= kfirst) { \
            const f32x4 v = xraw_f32(XQ[j_]) * RQ[j_]; s = s + v; ring[(k_ & 15) * (NWAVES * 64)] = v; \
            if (k_ >= 0) { const int tl = tl0 + k_; const float inv = 1.0f / (float)((tl + 1 < w) ? (tl + 1) : w); \
                const f32x4 d = Gc * (s * inv - v); v2u o; o.x = pk2(d.x, d.y); o.y = pk2(d.z, d.w); \
                *(GAS v2u*)(dout + (size_t)(t0 + k_) * D + c0) = o; \
                if (tl - (w - 1) >= 0) s = s - ring[((k_ - (w - 1)) & 15) * (NWAVES * 64)]; } } } } } while (0)
        PD_LOAD(XA, RA, -16); PD_LOAD(XB, RB, -8);
        PD_PROC(XA, RA, -16); PD_LOAD(XA, RA, 0);
        PD_PROC(XB, RB, -8);  PD_LOAD(XB, RB, 8);
        PD_PROC(XA, RA, 0);   PD_LOAD(XA, RA, 16);
        PD_PROC(XB, RB, 8);   PD_LOAD(XB, RB, 24);
        PD_PROC(XA, RA, 16);
        PD_PROC(XB, RB, 24);
#undef PD_LOAD
#undef PD_PROC
    }
}

constexpr int NP_TROW = 1032;
constexpr int NP_TILE = 0, NP_TLO = 16 * NP_TROW * 2, NP_PART = 66048, NP_LOGI = NP_PART + 16384, NP_PE = NP_LOGI + 2048, NP_PPOS = NP_PE + 4096, NP_PG = NP_PPOS + 4096, NP_PPAIR = NP_PG + 4096, NP_LCNT = NP_PPAIR + 4096, NP_BASE = NP_LCNT + 128, NP_TOPV = NP_BASE + 128, NP_MOD = NP_TOPV + 256, NP_END = NP_MOD + 3 * 4096;
static_assert(NP_END <= RING_BYTES && NP_MOD % 16 == 0, "norm phase LDS");
#define LDS_BARRIER() do { asm volatile("s_waitcnt lgkmcnt(0)" ::: "memory"); __builtin_amdgcn_s_barrier(); asm volatile("" ::: "memory"); } while (0)
template <bool FOX>
__device__ __forceinline__ void norm_proj_phase(Frame& F0, const bf16* xsrc, bf16* xdst, const unsigned char* ys, const float* g2v, const float* Gv, const float* Sv,
                                                const float* W, int w_ld, const float* bias, bf16* hout, float* LF, unsigned* gcnt, int* slot_pair, float* slot_gate, bool dry = false) {
    constexpr int NEC = FOX ? 16 : 32, NEH = NEC / 16, NYK = FOX ? 4 : 1;
    Frame F = F0; { int t_ = F0.tid; asm volatile("" : "+v"(t_)); F.tid = t_; F.lane = t_ & 63; F.wave = __builtin_amdgcn_readfirstlane(t_ >> 6); }
    LAS unsigned short* THI = (LAS unsigned short*)(F.lds + NP_TILE); LAS unsigned short* TLO = (LAS unsigned short*)(F.lds + NP_TLO); LAS float* PART = (LAS float*)(F.lds + NP_PART); LAS float* LOGI = (LAS float*)(F.lds + NP_LOGI);
    LAS int* P_E = (LAS int*)(F.lds + NP_PE); LAS int* P_POS = (LAS int*)(F.lds + NP_PPOS); LAS float* P_G = (LAS float*)(F.lds + NP_PG); LAS int* P_PAIR = (LAS int*)(F.lds + NP_PPAIR);
    LAS int* LCNT = (LAS int*)(F.lds + NP_LCNT); LAS int* BASE = (LAS int*)(F.lds + NP_BASE); LAS float* TOPV = (LAS float*)(F.lds + NP_TOPV); LAS float* MOD = (LAS float*)(F.lds + NP_MOD);
    const int lane = F.lane, w = F.wave, r = lane & 15, q = lane >> 4;
    const int NT = T / 16, per = (NT + F.G - 1) / F.G, tl0 = F.bid * per, tl1 = (tl0 + per < NT) ? tl0 + per : NT;
    v2u xn[2][4]; unsigned yn[2][NYK][4];
#define NP_LOADX(tlx) do { _Pragma("unroll") for (int rr_ = 0; rr_ < 2; ++rr_) { const int tk_ = (tlx) * 16 + 2 * w + rr_; const GAS v2u* xr_ = (const GAS v2u*)(xsrc + (size_t)tk_ * D) + lane; \
        _Pragma("unroll") for (int j_ = 0; j_ < 4; ++j_) xn[rr_][j_] = xr_[64 * j_]; \
        if (FOX) { _Pragma("unroll") for (int k_ = 0; k_ < NYK; ++k_) { _Pragma("unroll") for (int j_ = 0; j_ < 4; ++j_) yn[rr_][k_][j_] = *((const GAS unsigned*)(ys + ((size_t)tk_ * 4 + k_) * D) + lane + 64 * j_); } } } } while (0)
    if (tl0 < tl1) NP_LOADX(tl0);
    const float bias_e = (F.tid < 16 * NEC) ? bias[F.tid % NEC] : 0.f;
    typedef short bf16x8v __attribute__((ext_vector_type(8)));
    v4u whi[4][NEH], wlo[4][NEH];
#pragma unroll
    for (int s = 0; s < 4; ++s)
#pragma unroll
        for (int eh = 0; eh < NEH; ++eh) { float wv[8];
#pragma unroll
            for (int j = 0; j < 8; ++j) wv[j] = W[(size_t)(128 * w + 32 * s + 8 * q + j) * w_ld + 16 * eh + r];
#pragma unroll
            for (int p = 0; p < 4; ++p) { const unsigned hb = pk2(wv[2 * p], wv[2 * p + 1]); whi[s][eh][p] = hb; wlo[s][eh][p] = pk2(wv[2 * p] - bflo(hb), wv[2 * p + 1] - bfhi(hb)); } }
    if (!FOX) { if (F.tid < 32) LCNT[F.tid] = 0; }
    int bcur = -1;
    int nloc = 0;
    for (int tl = tl0; tl < tl1; ++tl, ++nloc) {
        const int b = tl >> 9;
        if (b != bcur) {
            for (int i = F.tid; i < 768; i += NWAVES * 64) { const int vec = i >> 8, c4 = i & 255;
                if (FOX || vec > 0) { const float* src = (vec == 0) ? g2v : (vec == 1) ? Gv : Sv; f32x4 val = *((const GAS f32x4*)(src + (size_t)b * 6 * D) + c4);
                    if (vec == 0) val = val * (1.0f / pg8::YS_SCALE);
                    *(LAS f32x4*)(MOD + vec * 1024 + 4 * c4) = val; } }
            bcur = b;
            LDS_BARRIER();
        }
        v2u xc[2][4]; unsigned yc[2][NYK][4];
#pragma unroll
        for (int rr = 0; rr < 2; ++rr) {
#pragma unroll
            for (int j = 0; j < 4; ++j) xc[rr][j] = xn[rr][j];
            if (FOX) {
#pragma unroll
                for (int k = 0; k < NYK; ++k)
#pragma unroll
                    for (int j = 0; j < 4; ++j) yc[rr][k][j] = yn[rr][k][j]; } }
        if (tl + 1 < tl1) NP_LOADX(tl + 1);
#pragma unroll
        for (int rr = 0; rr < 2; ++rr) {
            const int row = 2 * w + rr, tok = tl * 16 + row;
            f32x4 v[4];
#pragma unroll
            for (int j = 0; j < 4; ++j) v[j] = (f32x4){bflo(xc[rr][j].x), bfhi(xc[rr][j].x), bflo(xc[rr][j].y), bfhi(xc[rr][j].y)};
            if (FOX) {
#pragma unroll
                for (int j = 0; j < 4; ++j) { const f32x4 g = *(const LAS f32x4*)(MOD + 4 * lane + 256 * j);
                    v[j] = v[j] + g * ys_sum4(yc[rr][0][j], yc[rr][NYK > 1 ? 1 : 0][j], yc[rr][NYK > 2 ? 2 : 0][j], yc[rr][NYK > 3 ? 3 : 0][j]); }
#pragma unroll
                for (int j = 0; j < 4; ++j) stx4_bf(xdst, (size_t)tok * D + 4 * lane + 256 * j, v[j]);
            }
            float ss = 0.f;
#pragma unroll
            for (int j = 0; j < 4; ++j) ss += (v[j].x * v[j].x + v[j].y * v[j].y) + (v[j].z * v[j].z + v[j].w * v[j].w);
            const float rinv = 1.0f / sqrtf(wave_sum(ss) * (1.0f / D) + EPS);
#pragma unroll
            for (int j = 0; j < 4; ++j) {
                const f32x4 g = *(const LAS f32x4*)(MOD + 1024 + 4 * lane + 256 * j), sh = *(const LAS f32x4*)(MOD + 2048 + 4 * lane + 256 * j);
                const f32x4 h = v[j] * rinv * g + sh;
                *((GAS unsigned*)((unsigned char*)hout + (size_t)tok * D) + lane + 64 * j) = pg8::pk4_fp8(h.x * pg8::FP8_SA, h.y * pg8::FP8_SA, h.z * pg8::FP8_SA, h.w * pg8::FP8_SA);
                { v2u hh; hh.x = pk2(h.x, h.y); hh.y = pk2(h.z, h.w); v2u hl; hl.x = pk2(h.x - bflo(hh.x), h.y - bfhi(hh.x)); hl.y = pk2(h.z - bflo(hh.y), h.w - bfhi(hh.y));
                  *(LAS v2u*)(THI + row * NP_TROW + 256 * j + 4 * lane) = hh; *(LAS v2u*)(TLO + row * NP_TROW + 256 * j + 4 * lane) = hl; }
            }
        }
        LDS_BARRIER();
        {
            f32x4 acc[NEH];
#pragma unroll
            for (int eh = 0; eh < NEH; ++eh) acc[eh] = pg8::zero4();
#pragma unroll
            for (int s = 0; s < 4; ++s) { const v4u ah = *(const LAS v4u*)(THI + r * NP_TROW + 128 * w + 32 * s + 8 * q), al = *(const LAS v4u*)(TLO + r * NP_TROW + 128 * w + 32 * s + 8 * q);
#pragma unroll
                for (int eh = 0; eh < NEH; ++eh) {
                    acc[eh] = __builtin_amdgcn_mfma_f32_16x16x32_bf16(__builtin_bit_cast(bf16x8v, ah), __builtin_bit_cast(bf16x8v, whi[s][eh]), acc[eh], 0, 0, 0);
                    acc[eh] = __builtin_amdgcn_mfma_f32_16x16x32_bf16(__builtin_bit_cast(bf16x8v, al), __builtin_bit_cast(bf16x8v, whi[s][eh]), acc[eh], 0, 0, 0);
                    acc[eh] = __builtin_amdgcn_mfma_f32_16x16x32_bf16(__builtin_bit_cast(bf16x8v, ah), __builtin_bit_cast(bf16x8v, wlo[s][eh]), acc[eh], 0, 0, 0); } }
#pragma unroll
            for (int eh = 0; eh < NEH; ++eh)
#pragma unroll
                for (int i = 0; i < 4; ++i) PART[(w * 16 + 4 * q + i) * 32 + 16 * eh + r] = acc[eh][i];
        }
        LDS_BARRIER();
        float logit_own = bias_e;
        if (F.tid < 16 * NEC) { const int token = F.tid / NEC, e = F.tid % NEC;
#pragma unroll
            for (int ww = 0; ww < 8; ++ww) logit_own += PART[(ww * 16 + token) * 32 + e];
            if (!FOX) LOGI[token * 32 + e] = logit_own; }
        LDS_WAIT(); asm volatile("" ::: "memory");
        if (FOX) {
            if (F.tid < 256) { const int token = F.tid >> 4, hh = F.tid & 15; const float z = logit_own;
                const float lf = fminf(z, 0.f) - 0.69314718056f * __builtin_amdgcn_logf(1.0f + __builtin_amdgcn_exp2f(-1.4426950408889634f * fabsf(z)));
                const int tg = tl * 16 + token; LF[((size_t)(tg >> 13) * NH + hh) * SEQ + (tg & (SEQ - 1))] = lf; }
        } else if (nloc < 16) {
            const int token = F.tid >> 5, e = F.tid & 31; const LAS float* lg = LOGI + token * 32; const float v = lg[e]; int rank = 0;
#pragma unroll
            for (int e2 = 0; e2 < 32; ++e2) { const float o = lg[e2]; rank += (o > v || (o == v && e2 < e)) ? 1 : 0; }
            if (rank < 4) TOPV[token * 4 + rank] = v;
            LDS_WAIT(); asm volatile("" ::: "memory");
            if (rank < 4) { const float t0 = TOPV[token * 4], e0 = __expf(TOPV[token * 4 + 1] - t0), e1 = __expf(TOPV[token * 4 + 2] - t0), e2x = __expf(TOPV[token * 4 + 3] - t0);
                const float gate = __expf(v - t0) / (1.0f + e0 + e1 + e2x);
                const int pl = nloc * 64 + token * 4 + rank;
                const int lp = __hip_atomic_fetch_add((int*)(LCNT + e), 1, __ATOMIC_RELAXED, __HIP_MEMORY_SCOPE_WORKGROUP);
                P_E[pl] = e; P_POS[pl] = lp; P_G[pl] = gate; P_PAIR[pl] = (tl * 16 + token) * 4 + rank; }
        }
    }
#undef NP_LOADX
    if (!FOX) {
        __syncthreads();
        if (F.tid < 32) BASE[F.tid] = dry ? 0 : (int)__hip_atomic_fetch_add(gcnt + F.tid, (unsigned)LCNT[F.tid], RLX_AGENT);
        __syncthreads();
        const int np = dry ? 0 : (nloc < 16 ? nloc : 16) * 64;
        for (int pl = F.tid; pl < np; pl += NWAVES * 64) { const int e = P_E[pl]; const size_t slot = (size_t)e * T + BASE[e] + P_POS[pl];
            slot_pair[slot] = P_PAIR[pl]; slot_gate[slot] = P_G[pl]; }
    }
    __syncthreads();
}

__device__ __forceinline__ void fox_scan(Frame& F0, const float* LF, float* FB) {
    Frame F = F0; { int t_ = F0.tid; asm volatile("" : "+v"(t_)); F.tid = t_; F.lane = t_ & 63; F.wave = __builtin_amdgcn_readfirstlane(t_ >> 6); }
    LAS float* wt = (LAS float*)(F.lds + RING_OFF);
    for (int seq = F.bid; seq < BATCH * NH; seq += F.G) {
        const GAS f32x4* src = (const GAS f32x4*)(LF + (size_t)seq * SEQ + 16 * F.tid);
        f32x4 v[4];
#pragma unroll
        for (int j = 0; j < 4; ++j) v[j] = src[j];
        float c[16]; float run = 0.f;
#pragma unroll
        for (int j = 0; j < 4; ++j) { run += v[j].x; c[4 * j] = run; run += v[j].y; c[4 * j + 1] = run; run += v[j].z; c[4 * j + 2] = run; run += v[j].w; c[4 * j + 3] = run; }
        const float incl = wave_incl_scan(run);
        if (F.lane == 63) wt[F.wave] = incl;
        __syncthreads();
        float off = incl - run;
        for (int ww = 0; ww < F.wave; ++ww) off += wt[ww];
        GAS f32x4* dst = (GAS f32x4*)(FB + (size_t)seq * SEQ + 16 * F.tid);
#pragma unroll
        for (int j = 0; j < 4; ++j) dst[j] = (f32x4){(off + c[4 * j]) * -1.4426950408889634f, (off + c[4 * j + 1]) * -1.4426950408889634f, (off + c[4 * j + 2]) * -1.4426950408889634f, (off + c[4 * j + 3]) * -1.4426950408889634f};
        __syncthreads();
    }
}

constexpr int UL_OFF = SCHED_OFF + 320, UL_MAX = 24;
__device__ __forceinline__ void moe_setup(Frame& F0, const unsigned* gcnt, int nN, bool reuse = false) {
    Frame F = F0; { int t_ = F0.tid; asm volatile("" : "+v"(t_)); F.tid = t_; F.lane = t_ & 63; F.wave = __builtin_amdgcn_readfirstlane(t_ >> 6); }
    LAS int* CNT = (LAS int*)(F.lds + SCHED_OFF); LAS int* TPRE = CNT + 32; LAS int* UL = (LAS int*)(F.lds + UL_OFF);
    __syncthreads();
    if (!reuse) {
        if (F.tid < 32) { const unsigned c = __hip_atomic_load(gcnt + F.tid, RLX_AGENT); CNT[F.tid] = (int)(c < (unsigned)T ? c : (unsigned)T); }
        __syncthreads();
        if (F.tid == 0) { int a = 0; for (int e = 0; e < 32; ++e) { TPRE[e] = a; a += (CNT[e] + 255) >> 8; } TPRE[32] = a < MAXMT ? a : MAXMT; }
        __syncthreads();
    }
    if (F.tid < UL_MAX) { const int MT = TPRE[32]; int pm = -1, pn = 0, e = 0;
        if (F.tid < UL_MAX - 1 && pg8::tile_order(F.tid, F.G, F.bid, MT, nN, pm, pn)) { for (int k = 0; k < 31; ++k) if (TPRE[k + 1] <= pm) e = k + 1; } else pm = -1;
        LAS int* p = UL + 5 * F.tid; p[0] = pm; p[1] = pn; p[2] = e; p[3] = CNT[e]; p[4] = pm - TPRE[e]; }
    __syncthreads();
}
__device__ __forceinline__ void qk_stats_phase(Frame& F0, const bf16* Q, const bf16* K, unsigned* QN2, unsigned* KN2) {
    Frame F = F0; { int t_ = F0.tid; asm volatile("" : "+v"(t_)); F.tid = t_; F.lane = t_ & 63; F.wave = __builtin_amdgcn_readfirstlane(t_ >> 6); }
    const int gw = F.bid * NWAVES + F.wave, NGW = F.G * NWAVES;
    for (int it = gw; it < T / 16; it += NGW) {
        const int t0 = it * 16; float qm = 0.f, km = 0.f;
#pragma unroll 4
        for (int i = 0; i < 16; ++i) {
            const GAS v4u* qp = (const GAS v4u*)(Q + (size_t)(t0 + i) * D + 16 * F.lane); const GAS v4u* kp = (const GAS v4u*)(K + (size_t)(t0 + i) * D + 16 * F.lane);
            const v4u qa = qp[0], qb = qp[1], ka = kp[0], kb = kp[1];
            float qs = 0.f, ks = 0.f;
#pragma unroll
            for (int e = 0; e < 4; ++e) { qs += bflo(qa[e]) * bflo(qa[e]) + bfhi(qa[e]) * bfhi(qa[e]) + bflo(qb[e]) * bflo(qb[e]) + bfhi(qb[e]) * bfhi(qb[e]);
                                          ks += bflo(ka[e]) * bflo(ka[e]) + bfhi(ka[e]) * bfhi(ka[e]) + bflo(kb[e]) * bflo(kb[e]) + bfhi(kb[e]) * bfhi(kb[e]); }
            qs += dppf<0xB1>(qs); qs += dppf<0x4E>(qs); ks += dppf<0xB1>(ks); ks += dppf<0x4E>(ks);
            qm = fmaxf(qm, qs); km = fmaxf(km, ks);
        }
        if ((F.lane & 3) == 0) { const int b = t0 >> 13, h = F.lane >> 2, qb = (t0 & (SEQ - 1)) >> 8;
            __hip_atomic_fetch_max(QN2 + (b * NH + h) * 32 + qb, __float_as_uint(qm), RLX_AGENT); __hip_atomic_fetch_max(KN2 + b * NH + h, __float_as_uint(km), RLX_AGENT); }
    }
}
constexpr int PH_FINAL = 1 + 8 * DEPTH, NPH = PH_FINAL + 1;
struct Args { const float* in[18]; float* out; unsigned char* ws; int ph_lo, ph_hi; };
#define KARG() ({ const __attribute__((address_space(4))) Args* p_ = (const __attribute__((address_space(4))) Args*)__builtin_amdgcn_kernarg_segment_ptr(); asm volatile("" : "+s"(p_)); p_; })
#define MKFRAME(F, ws) Frame F; F.lds = (LAS unsigned char*)lds; F.MISC = (volatile LAS unsigned*)(F.lds + MISC_OFF); F.tid = threadIdx.x; F.lane = F.tid & 63; F.wave = __builtin_amdgcn_readfirstlane(F.tid >> 6); { int g_ = gridDim.x, b_ = blockIdx.x; asm volatile("" : "+s"(g_), "+s"(b_)); F.G = g_; F.bid = b_; } F.ctl = (gu32*)((ws) + WS_CTL)
__global__ void __launch_bounds__(NWAVES * 64, 2) enc_fwd(Args args) {
    extern __shared__ __attribute__((aligned(16))) unsigned char lds[];
    {
        for (int u = threadIdx.x; u < (LDS_BYTES - IDX_OFF) / 4; u += NWAVES * 64) ((LAS unsigned*)((LAS unsigned char*)lds + IDX_OFF))[u] = 0u;
        __syncthreads();
        if (MK_N_LAUNCHES == 1) { const auto* ap = KARG(); (void)xcd_barrier_post((unsigned*)((gu32*)(ap->ws + WS_CTL) + CW_BAR), (volatile LAS unsigned*)((LAS unsigned char*)lds + MISC_OFF) + 8); }
    }
#define SEAM() do { if (MK_N_LAUNCHES == 1) { const auto* ap_ = KARG(); XcdBarrier bar_; bar_.bar = (unsigned*)((gu32*)(ap_->ws + WS_CTL) + CW_BAR); bar_.x = xb_xcc_id(); bar_.st = (volatile LAS unsigned*)((LAS unsigned char*)lds + MISC_OFF) + 8; xcd_barrier(bar_); } } while (0)
    const int lo = args.ph_lo, hi = args.ph_hi;
#ifndef DBG_MASK
#define DBG_MASK 0xFFFF
#endif
#define EN(b) ((DBG_MASK >> (b)) & 1)
#ifndef DBG_DUP
#define DBG_DUP 0
#endif
#define REPS(b) for (int rep_ = 0; rep_ < (((DBG_DUP >> (b)) & 1) ? 2 : 1); ++rep_)
#define IN(k) (lo <= (k) && (k) < hi)
#define P_MODV(ws) ((float*)((ws) + WS_MODV))
#define P_HB(ws) ((bf16*)((ws) + WS_HB))
#define P_YS(ws) ((unsigned char*)((ws) + WS_YS))

    if (EN(0) && IN(0)) {
        REPS(0) { const auto* ap = KARG(); unsigned char* ws = ap->ws; MKFRAME(F, ws);
            ProIn P{ap->in[1], ap->in[2], ap->in[3], ap->in[4], ap->in[5], ap->in[6], ap->in[7], ap->in[8], ap->in[10], ap->in[13], ap->in[15]};
            p0_prologue(F, P, ws);
            if (MK_NBRANCH > 0) rows_phase<0, false>(F, false, ap->in[0], nullptr, P_YS(ws), P_MODV(ws), (float*)(ws + WS_R1), nullptr);
            SEAM(); }
    }
#pragma unroll 1
    for (int L = 0; L < DEPTH; ++L) {
        const int ph = 1 + 8 * L, jx = L >> 1;
        const bool odd = (L & 1) != 0, do_mix = (2 * L < MK_NBRANCH), do_moe = (2 * L + 1 < MK_NBRANCH);
#define P_XB(ws) ((bf16*)((ws) + WS_XB))
#define MV(ws) (P_MODV(ws) + (size_t)L * BATCH * 6 * D)
#define MVP(ws) (P_MODV(ws) + (size_t)(L > 0 ? L - 1 : 0) * BATCH * 6 * D)
        if (do_mix) {
            if (!odd) {
                if (EN(1) && IN(ph + 0) && L > 0) REPS(1) { const auto* ap = KARG(); unsigned char* ws = ap->ws; MKFRAME(F, ws); const bool dry = (rep_ == 0) && ((DBG_DUP >> 1) & 1);
                    rows_phase<0, true>(F, true, P_XB(ws), dry ? (void*)(ws + WS_ACT) : (void*)P_XB(ws), P_YS(ws), MVP(ws) + 5 * D, (float*)(ws + WS_R1), nullptr); SEAM(); }
                if (EN(2) && IN(ph + 1)) REPS(2) { const auto* ap = KARG(); unsigned char* ws = ap->ws; MKFRAME(F, ws);
                    if (L == 0) pool_d_phase<false>(F, ap->in[0], (const float*)(ws + WS_R1), MV(ws) + 1 * D, P_HB(ws)); else pool_d_phase<true>(F, P_XB(ws), (const float*)(ws + WS_R1), MV(ws) + 1 * D, P_HB(ws)); SEAM(); }
            } else {
                if (EN(3) && IN(ph + 0)) REPS(3) { const auto* ap = KARG(); unsigned char* ws = ap->ws; MKFRAME(F, ws); const bool dry = (rep_ == 0) && ((DBG_DUP >> 3) & 1);
                    norm_proj_phase<true>(F, P_XB(ws), dry ? (bf16*)(ws + WS_ACT) : P_XB(ws), P_YS(ws), MVP(ws) + 5 * D, MV(ws) + 1 * D, MV(ws) + 0 * D, ap->in[8] + (size_t)jx * D * FOX_LD + NQKV, FOX_LD, ap->in[9] + jx * NH, dry ? (bf16*)(ws + WS_K) : P_HB(ws), (float*)(ws + (dry ? WS_FB : WS_LF)), nullptr, nullptr, nullptr); SEAM(); }
                if (EN(4) && IN(ph + 1)) {
                    REPS(4) { const auto* ap = KARG(); unsigned char* ws = ap->ws; MKFRAME(F, ws);
                    fox_scan(F, (const float*)(ws + WS_LF), (float*)(ws + WS_FB));
                    pg8::SchedDenseT<true> S{(const char*)P_HB(ws), (const char*)(ws + WS_WQKV) + (size_t)jx * NQKV * D, (size_t)256 * D, (size_t)256 * D, 0, T / 256, NQKV / 256, F.G, F.bid};
                    pg8::EpiQKV E{(bf16*)(ws + WS_Q), (size_t)(WS_K - WS_Q) / 2, attn_body::C2, 1.0f / (pg8::FP8_SA * pg8::FP8_SW), (unsigned*)(F.ctl + CW_QN2) + jx * 4096, (unsigned*)(F.ctl + CW_KN2) + jx * 128};
                    pg8::gemm_phase<pg8::EpiQKV, pg8::SchedDenseT<true>, true, true>(F.lds + RING_OFF, F.lds + IDX_OFF, D / 128, D, D, S, E); SEAM(); }
                }
                if (EN(5) && IN(ph + 2)) {
                    static_assert(attn_body::ATTN_LDS_BYTES <= RING_BYTES && attn_body::ATTN_PITCH == D, "attention body geometry vs frame");
                    REPS(5) { const auto* ap = KARG(); unsigned char* ws = ap->ws; gu32* ctl = (gu32*)(ws + WS_CTL);
                    const attn_body::AttnTensors AT{(const attn_body::bf16*)(ws + WS_Q), (const attn_body::bf16*)(ws + WS_K), (const attn_body::bf16*)(ws + WS_V), (attn_body::bf16*)(ws + WS_HB), (const float*)(ws + WS_FB), (const unsigned*)(ctl + CW_QN2) + jx * 4096, (const unsigned*)(ctl + CW_KN2) + jx * 128};
                    int g_ = gridDim.x, b_ = blockIdx.x; asm volatile("" : "+s"(g_), "+s"(b_)); const attn_body::StaticOrder S(g_, b_);
                    attn_body::attn_phase<attn_body::StaticOrder>((char*)lds + RING_OFF, AT, S, (volatile LAS int*)((LAS unsigned char*)lds + SCHED_OFF)); SEAM(); }
                }
            }
            if (EN(6) && IN(ph + (odd ? 3 : 2))) REPS(6) { const auto* ap = KARG(); unsigned char* ws = ap->ws; MKFRAME(F, ws); const bool dry = (rep_ == 0) && ((DBG_DUP >> 6) & 1);
                if (!odd) {
                    pg8::SchedDense S{(const char*)P_HB(ws), (const char*)((bf16*)(ws + WS_WPOOL) + (size_t)jx * 4 * 65536), (size_t)256 * D * 2, (size_t)256 * 256 * 2, 512, T / 256, 4, F.G, F.bid};
                    pg8::EpiResid E{(L == 0) ? (const void*)ap->in[0] : (const void*)P_XB(ws), L != 0, dry ? (bf16*)(ws + WS_ACT) : P_XB(ws), MV(ws) + 2 * D, 6 * D, 1.0f};
                    pg8::gemm_phase<pg8::EpiResid, pg8::SchedDense, true, false>(F.lds + RING_OFF, F.lds + IDX_OFF, 256 / 64, D * 2, 256 * 2, S, E);
                } else {
                    pg8::SchedDenseT<true> S{(const char*)P_HB(ws), (const char*)(ws + WS_WO) + (size_t)jx * D * D, (size_t)256 * D, (size_t)256 * D, 0, T / 256, 4, F.G, F.bid};
                    pg8::EpiResid E{(const void*)P_XB(ws), true, dry ? (bf16*)(ws + WS_ACT) : P_XB(ws), MV(ws) + 2 * D, 6 * D, 1.0f / (attn_body::O_SCALE * pg8::FP8_SW)};
                    pg8::gemm_phase<pg8::EpiResid, pg8::SchedDenseT<true>, true, true>(F.lds + RING_OFF, F.lds + IDX_OFF, D / 128, D, D, S, E);
                }
                SEAM();
            }
        }
        if (do_moe) {
            const int pm = ph + (odd ? 4 : 3);
            if (EN(7) && IN(pm + 0)) REPS(7) { const auto* ap = KARG(); unsigned char* ws = ap->ws; MKFRAME(F, ws); const bool dry = (rep_ == 0) && ((DBG_DUP >> 7) & 1);
                norm_proj_phase<false>(F, P_XB(ws), nullptr, nullptr, nullptr, MV(ws) + 4 * D, MV(ws) + 3 * D, ap->in[11] + (size_t)L * D * NEXP, NEXP, ap->in[12] + L * NEXP, P_HB(ws), nullptr, (unsigned*)(F.ctl + CW_GCNT) + L * NEXP, (int*)(ws + WS_SLOTP), (float*)(ws + WS_SLOTG), dry); SEAM(); }
            if (EN(8) && IN(pm + 1)) { REPS(8) { const auto* ap = KARG(); unsigned char* ws = ap->ws; MKFRAME(F, ws);
                moe_setup(F, (unsigned*)(F.ctl + CW_GCNT) + L * NEXP, 2 * FF / 256);
                pg8::SchedMoe<true, false> S{(const char*)P_HB(ws), (const char*)(ws + WS_W1) + (size_t)L * NEXP * 2 * FF * D, 0, (size_t)2 * FF * D, (size_t)256 * D, (const int*)(ws + WS_SLOTP), (const float*)(ws + WS_SLOTG), ap->in[14] + (size_t)L * NEXP * 2 * FF, (const LAS int*)(F.lds + UL_OFF)};
                pg8::EpiSwiglu E{(unsigned char*)(ws + WS_ACT), 1.0f / (pg8::FP8_SA * pg8::FP8_SW)};
                pg8::gemm_phase<pg8::EpiSwiglu, pg8::SchedMoe<true, false>, true, true>(F.lds + RING_OFF, F.lds + IDX_OFF, D / 128, D, D, S, E); SEAM(); } }
            if (EN(9) && IN(pm + 2)) { REPS(9) { const auto* ap = KARG(); unsigned char* ws = ap->ws; MKFRAME(F, ws);
                moe_setup(F, (unsigned*)(F.ctl + CW_GCNT) + L * NEXP, D / 256, (MK_N_LAUNCHES == 1) && EN(8) && (DBG_DUP == 0));
                pg8::SchedMoe<false, true> S{(const char*)(ws + WS_ACT), (const char*)(ws + WS_W2) + (size_t)L * NEXP * D * FF, (size_t)256 * FF, (size_t)D * FF, (size_t)256 * FF, (const int*)(ws + WS_SLOTP), (const float*)(ws + WS_SLOTG), ap->in[16] + (size_t)L * NEXP * D, (const LAS int*)(F.lds + UL_OFF)};
                pg8::EpiScatter E{P_YS(ws), 1.0f / (pg8::FP8_SA * pg8::FP8_SW)};
                pg8::gemm_phase<pg8::EpiScatter, pg8::SchedMoe<false, true>, true, true>(F.lds + RING_OFF, F.lds + IDX_OFF, FF / 128, FF, FF, S, E); SEAM(); } }
        }
    }
    if (EN(10) && IN(PH_FINAL)) REPS(10) { const auto* ap = KARG(); unsigned char* ws = ap->ws; MKFRAME(F, ws); const bool dry = (rep_ == 0) && ((DBG_DUP >> 10) & 1);
        constexpr bool fin_comb = (MK_NBRANCH > 0) && (MK_NBRANCH % 2 == 0);
        constexpr int Lc = fin_comb ? MK_NBRANCH / 2 - 1 : 0;
        if (rep_ == 1) SEAM();
        static_assert(MK_NBRANCH > 0, "the final phase reads the bf16 working stream");
        rows_phase<1, true>(F, fin_comb, P_XB(ws), dry ? (void*)(ws + WS_ACT) : (void*)ap->out, P_YS(ws), P_MODV(ws) + (size_t)Lc * BATCH * 6 * D + 5 * D, nullptr, ap->in[17]);
    }
#undef IN
#undef SEAM
}

extern "C" void kernel_launch(void* const* d_in, const int* in_sizes, int n_in, void* d_out, int out_size, void* d_ws, size_t ws_size, hipStream_t stream) {
    static int grid = 0;
    if (grid == 0) {
        if (n_in != 18 || in_sizes[0] != T * D || out_size != T * D || ws_size < WS_END) { fprintf(stderr, "kernel_launch: unexpected shapes / workspace (n_in %d, in0 %d, out %d, ws %zu, need %zu); nothing launched\n", n_in, n_in > 0 ? in_sizes[0] : -1, out_size, ws_size, (size_t)WS_END); grid = -1; return; }
        int dev = 0, cus = 0, per_cu = 0;
        if (hipGetDevice(&dev) != hipSuccess || hipDeviceGetAttribute(&cus, hipDeviceAttributeMultiprocessorCount, dev) != hipSuccess) { fprintf(stderr, "kernel_launch: device query failed\n"); grid = -1; return; }
        if (hipFuncSetAttribute((const void*)enc_fwd, hipFuncAttributeMaxDynamicSharedMemorySize, LDS_BYTES) != hipSuccess) { fprintf(stderr, "kernel_launch: hipFuncSetAttribute failed\n"); grid = -1; return; }
        if (hipOccupancyMaxActiveBlocksPerMultiprocessor(&per_cu, (const void*)enc_fwd, NWAVES * 64, LDS_BYTES) != hipSuccess || per_cu < 1)
            fprintf(stderr, "kernel_launch: note: occupancy query reports %d workgroups per CU\n", per_cu);
        (void)hipGetLastError();
        grid = cus;
        if (grid != 256) fprintf(stderr, "kernel_launch: %d CUs (built and tuned for 256)\n", grid);
    }
    if (grid < 0) return;
    if (hipMemsetAsync((char*)d_ws + WS_CTL, 0, CTL_ZERO_BYTES, stream) != hipSuccess) { fprintf(stderr, "kernel_launch: hipMemsetAsync failed\n"); return; }
    Args a{};
    for (int i = 0; i < 18; ++i) a.in[i] = (const float*)d_in[i];
    a.out = (float*)d_out; a.ws = (unsigned char*)d_ws;
#if MK_N_LAUNCHES == 1
    a.ph_lo = 0; a.ph_hi = NPH;
    hipLaunchKernelGGL(enc_fwd, dim3(grid), dim3(NWAVES * 64), LDS_BYTES, stream, a);
    { const hipError_t le = hipPeekAtLastError(); if (le != hipSuccess) fprintf(stderr, "kernel_launch: launch failed: %s\n", hipGetErrorName(le)); }
#else
    for (int ph = 0; ph < NPH; ++ph) {
        if (ph > 0 && ph < PH_FINAL) { const int L = (ph - 1) / 8, p = (ph - 1) % 8; if (p >= ((L & 1) ? 7 : 6)) continue; }
        a.ph_lo = ph; a.ph_hi = ph + 1;
        hipLaunchKernelGGL(enc_fwd, dim3(grid), dim3(NWAVES * 64), LDS_BYTES, stream, a);
        const hipError_t le = hipPeekAtLastError(); if (le != hipSuccess) { fprintf(stderr, "kernel_launch: launch %d failed: %s\n", ph, hipGetErrorName(le)); break; }
    }
#endif
}
```

```cpp
#include <hip/hip_runtime.h>
#include <hip/hip_bf16.h>
#include <cstdio>
#include <cstdint>
#include <cmath>

#ifndef MK_N_LAUNCHES
#define MK_N_LAUNCHES 1
#endif
#ifndef MK_NBRANCH
#define MK_NBRANCH 8
#endif

constexpr int D = 1024, BATCH = 4, SEQ = 8192, T = BATCH * SEQ, DEPTH = 4, NEXP = 32, TOPK = 4, NH = 16, HD = 64, FF = 1024;
constexpr int NQKV = 3 * D, FOX_LD = 3 * D + NH;
constexpr float EPS = 1e-6f;
constexpr int MAXMT = T * TOPK / 256 + NEXP;

#define GAS __attribute__((address_space(1)))
#define LAS __attribute__((address_space(3)))

namespace pg8 {
#define PG8_LAS __attribute__((address_space(3)))
typedef unsigned short bf16_t;
typedef short bf16x8 __attribute__((ext_vector_type(8)));
typedef float f32x4 __attribute__((ext_vector_type(4)));
typedef float f32x2 __attribute__((ext_vector_type(2)));
typedef unsigned u32x4 __attribute__((ext_vector_type(4)));
typedef unsigned u32x2 __attribute__((ext_vector_type(2)));
typedef int v4i __attribute__((ext_vector_type(4)));
typedef int v8i __attribute__((ext_vector_type(8)));
constexpr int BM = 256, BK = 64, HALF = 128, HTB = HALF * BK * 2, STAGE_BYTES = 8 * HTB, NXCD = 8, WGM = 4;
constexpr int IDX_BYTES = 9216;

__host__ __device__ __forceinline__ int lds_byte(int r, int c) { const int st = (r >> 4) * 2 + (c >> 5), rr = r & 15, cc = c & 31, ob = rr * 64 + cc * 2; return st * 1024 + (ob ^ (((ob >> 9) & 1) << 5)); }
__host__ __device__ __forceinline__ void stage_rc(int b, int& R, int& C) { const int st = b / 1024, sb = b % 1024, swz = sb ^ (((sb >> 9) & 1) << 5); R = (st >> 1) * 16 + swz / 64; C = (st & 1) * 32 + (swz % 64) / 2; }
__host__ __device__ __forceinline__ int perm32(int rho) { const int n = rho >> 4, i = rho & 15; return 8 * (i >> 2) + 4 * n + (i & 3); }

__device__ __forceinline__ f32x4 zero4() { float z0, z1, z2, z3; asm volatile("v_mov_b32 %0, 0\n\tv_mov_b32 %1, 0\n\tv_mov_b32 %2, 0\n\tv_mov_b32 %3, 0" : "=v"(z0), "=v"(z1), "=v"(z2), "=v"(z3)); return (f32x4){z0, z1, z2, z3}; }
struct Unit { int pm, pn, e, cnt, mloc; };

__device__ __forceinline__ unsigned cvt_pk_bf16(float lo, float hi) { unsigned r; asm volatile("v_cvt_pk_bf16_f32 %0, %1, %2" : "=v"(r) : "v"(lo), "v"(hi)); return r; }

__device__ __forceinline__ float clamp448(float x) { return __builtin_amdgcn_fmed3f(x, -448.0f, 448.0f); }
__device__ __forceinline__ unsigned pk4_fp8(float a, float b, float c, float d) { int w; asm volatile("v_mov_b32 %0, 0" : "=v"(w));
    w = __builtin_amdgcn_cvt_pk_fp8_f32(clamp448(a), clamp448(b), w, false); w = __builtin_amdgcn_cvt_pk_fp8_f32(clamp448(c), clamp448(d), w, true); return (unsigned)w; }
constexpr float FP8_SW = 64.0f, FP8_SA = 4.0f;

__device__ __forceinline__ bool tile_order(int i, int G, int c, int nM, int nN, int& pm, int& pn) {
    const int nwg = nM * nN; const long L = (long)i * G + c; if (L >= nwg) return false;
    int wgid = (int)L; { const int q = nwg / NXCD, r = nwg % NXCD, xcd = wgid % NXCD, off = wgid / NXCD; wgid = (xcd < r ? xcd * (q + 1) : r * (q + 1) + (xcd - r) * q) + off; }
    const int nig = WGM * nN, gid = wgid / nig, fm = gid * WGM, gsz = (nM - fm) < WGM ? (nM - fm) : WGM;
    pm = fm + ((wgid % nig) % gsz); pn = (wgid % nig) / gsz; return true;
}

template <bool RO = false> struct SchedDenseT {
    static constexpr bool IDX = false, GATHER_A = false, GATE = false, ROWOFF_A = RO;
    const char* A; const char* Bt; size_t tstepA, tstepB; int a_pn_bytes; int nM, nN, G, c;
    __device__ __forceinline__ bool next(int i, Unit& u) const { u.e = 0; u.cnt = 256; u.mloc = 0; return tile_order(i, G, c, nM, nN, u.pm, u.pn); }
    __device__ __forceinline__ void ptrs(const Unit& u, const char*& cA, const char*& cB) const { cA = A + (RO ? (size_t)0 : (size_t)u.pm * tstepA) + (size_t)u.pn * a_pn_bytes; cB = Bt + (size_t)u.pn * tstepB; }
    __device__ __forceinline__ void issue_idx(const Unit&, PG8_LAS unsigned char*, int, int, int) const {}
};
typedef SchedDenseT<false> SchedDense;
template <bool GA, bool GT>
struct SchedMoe {
    static constexpr bool IDX = true, GATHER_A = GA, GATE = GT, ROWOFF_A = !GA;
    const char* A; const char* Bt; size_t tstepA, e_stepB, tstepB;
    const int* slot_pair; const float* slot_gate; const float* bias;
    const PG8_LAS int* ul;
    __device__ __forceinline__ bool next(int i, Unit& u) const {
        const PG8_LAS int* p = ul + 5 * i; const int pm = __builtin_amdgcn_readfirstlane(p[0]); if (pm < 0) return false;
        u.pm = pm; u.pn = __builtin_amdgcn_readfirstlane(p[1]); u.e = __builtin_amdgcn_readfirstlane(p[2]); u.cnt = __builtin_amdgcn_readfirstlane(p[3]); u.mloc = __builtin_amdgcn_readfirstlane(p[4]); return true;
    }
    __device__ __forceinline__ void ptrs(const Unit& u, const char*& cA, const char*& cB) const {
        cA = A; cB = Bt + (size_t)u.e * e_stepB + (size_t)u.pn * tstepB; }
    __device__ __forceinline__ void issue_idx(const Unit& u, PG8_LAS unsigned char* ldsx, int buf, int wid, int lane) const {
        asm volatile("" : "+v"(lane));
        int pos = u.mloc * 256 + (wid & 3) * 64 + lane; pos = pos < u.cnt ? pos : u.cnt - 1;
        const size_t off = (size_t)u.e * T + pos;
        if (wid < 4) __builtin_amdgcn_global_load_lds((const unsigned*)(slot_pair + off), (PG8_LAS unsigned*)(ldsx + buf * 1024 + wid * 256), 4, 0, 0);
        else if (GT) __builtin_amdgcn_global_load_lds((const unsigned*)(slot_gate + off), (PG8_LAS unsigned*)(ldsx + 3072 + buf * 1024 + (wid - 4) * 256), 4, 0, 0);
        if (GA) { if (wid >= 4) { const int w4 = wid - 4; const float* bp = bias + (size_t)u.e * 2048 + (w4 >> 1) * 1024 + u.pn * 128 + (w4 & 1) * 64 + lane;
                    __builtin_amdgcn_global_load_lds((const unsigned*)bp, (PG8_LAS unsigned*)(ldsx + 6144 + buf * 1024 + w4 * 256), 4, 0, 0); } }
        else { if (wid < 4) { const float* bp = bias + (size_t)u.e * 1024 + u.pn * 256 + wid * 64 + lane;
                    __builtin_amdgcn_global_load_lds((const unsigned*)bp, (PG8_LAS unsigned*)(ldsx + 6144 + buf * 1024 + wid * 256), 4, 0, 0); } }
    }
};

template <int CTRL> __device__ __forceinline__ float dpp_maxf(float v) { return fmaxf(v, __builtin_bit_cast(float, __builtin_amdgcn_update_dpp(0, __builtin_bit_cast(int, v), CTRL, 0xF, 0xF, false))); }
struct EpiQKV {
    static constexpr int PERM = 1;
    bf16_t* O; size_t split_stride; float scale0, sall; unsigned* qn2; unsigned* kn2;
    __device__ __forceinline__ void operator()(const f32x4 (&acc)[2][2][4][2], const Unit& u, int wr, int wc, int fr, int fq, PG8_LAS unsigned char*, int) const {
        const int row0 = u.pm * BM + wr * 64 + fr; int colt = u.pn * BM; const int t = colt / 1024; bf16_t* base = O + (size_t)t * split_stride; colt -= t * 1024;
        const float sc = ((t == 0) ? scale0 : 1.f) * sall; const int col0 = colt + wc * 32 + 8 * fq;
        float mx[2] = {0.f, 0.f};
#pragma unroll
        for (int ai = 0; ai < 2; ++ai)
#pragma unroll
            for (int m = 0; m < 4; ++m) { bf16_t* rowp = base + (size_t)(row0 + ai * HALF + m * 16) * 1024 + col0;
#pragma unroll
                for (int bj = 0; bj < 2; ++bj) { const f32x4 v0 = acc[ai][bj][m][0] * sc, v1 = acc[ai][bj][m][1] * sc;
                    u32x4 w; w.x = cvt_pk_bf16(v0[0], v0[1]); w.y = cvt_pk_bf16(v0[2], v0[3]); w.z = cvt_pk_bf16(v1[0], v1[1]); w.w = cvt_pk_bf16(v1[2], v1[3]);
                    *(u32x4*)(rowp + bj * HALF) = w;
                    if (t < 2) { float ss = (v0[0] * v0[0] + v0[1] * v0[1]) + (v0[2] * v0[2] + v0[3] * v0[3]) + (v1[0] * v1[0] + v1[1] * v1[1]) + (v1[2] * v1[2] + v1[3] * v1[3]);
                        { const auto r = __builtin_amdgcn_permlane16_swap(__float_as_uint(ss), __float_as_uint(ss), false, false); ss = __uint_as_float(r[0]) + __uint_as_float(r[1]); }
                        { const auto r = __builtin_amdgcn_permlane32_swap(__float_as_uint(ss), __float_as_uint(ss), false, false); ss = __uint_as_float(r[0]) + __uint_as_float(r[1]); }
                        mx[bj] = fmaxf(mx[bj], ss); } } }
        if (t < 2) {
#pragma unroll
            for (int bj = 0; bj < 2; ++bj) { float m_ = mx[bj]; m_ = dpp_maxf<0xB1>(m_); m_ = dpp_maxf<0x4E>(m_); m_ = dpp_maxf<0x141>(m_); m_ = dpp_maxf<0x140>(m_);
                if (fr == 0 && fq == 0) { const int bh = (u.pm >> 5) * 16 + (colt >> 6) + bj * 2 + (wc >> 1), half = wc & 1;
                    if (t == 0) __hip_atomic_fetch_max(qn2 + ((size_t)bh * 32 + (u.pm & 31)) * 2 + half, __float_as_uint(m_), __ATOMIC_RELAXED, __HIP_MEMORY_SCOPE_AGENT);
                    else        __hip_atomic_fetch_max(kn2 + (size_t)bh * 2 + half, __float_as_uint(m_), __ATOMIC_RELAXED, __HIP_MEMORY_SCOPE_AGENT); } }
        }
    }
};
struct EpiResid {
    static constexpr int PERM = 1;
    const void* src; bool src_bf; bf16_t* dst; const float* cs; int cs_bstride; float s;
    __device__ __forceinline__ void operator()(const f32x4 (&acc)[2][2][4][2], const Unit& u, int wr, int wc, int fr, int fq, PG8_LAS unsigned char*, int) const {
        const int row0 = u.pm * BM + wr * 64 + fr, col0 = u.pn * BM + wc * 32 + 8 * fq; const int b = (u.pm * BM) / SEQ;
        f32x4 cv[2][2];
#pragma unroll
        for (int bj = 0; bj < 2; ++bj)
#pragma unroll
            for (int n = 0; n < 2; ++n) cv[bj][n] = *(const f32x4*)(cs + (size_t)b * cs_bstride + col0 + bj * HALF + 4 * n) * s;
        if (src_bf) {
            u32x4 wq[2][4];
#define ER_OFF(bt, mm) ((size_t)(row0 + ((bt) >> 1) * HALF + (2 * ((bt) & 1) + (mm)) * 16) * 1024 + col0)
#define ER_LD(bt, W) do { _Pragma("unroll") for (int mm = 0; mm < 2; ++mm) { _Pragma("unroll") for (int bj = 0; bj < 2; ++bj) W[mm * 2 + bj] = *(const u32x4*)((const bf16_t*)src + ER_OFF(bt, mm) + bj * HALF); } } while (0)
#define ER_ST(bt, W) do { _Pragma("unroll") for (int mm = 0; mm < 2; ++mm) { _Pragma("unroll") for (int bj = 0; bj < 2; ++bj) { const u32x4 w = W[mm * 2 + bj]; \
                const f32x4 x0 = (f32x4){__uint_as_float(w.x << 16), __uint_as_float(w.x & 0xffff0000u), __uint_as_float(w.y << 16), __uint_as_float(w.y & 0xffff0000u)}; \
                const f32x4 x1 = (f32x4){__uint_as_float(w.z << 16), __uint_as_float(w.z & 0xffff0000u), __uint_as_float(w.w << 16), __uint_as_float(w.w & 0xffff0000u)}; \
                const f32x4 y0 = x0 + cv[bj][0] * acc[(bt) >> 1][bj][2 * ((bt) & 1) + mm][0], y1 = x1 + cv[bj][1] * acc[(bt) >> 1][bj][2 * ((bt) & 1) + mm][1]; \
                u32x4 o; o.x = cvt_pk_bf16(y0[0], y0[1]); o.y = cvt_pk_bf16(y0[2], y0[3]); o.z = cvt_pk_bf16(y1[0], y1[1]); o.w = cvt_pk_bf16(y1[2], y1[3]); \
                *(u32x4*)(dst + ER_OFF(bt, mm) + bj * HALF) = o; } } } while (0)
            ER_LD(0, wq[0]); ER_LD(1, wq[1]); asm volatile("" ::: "memory");
            ER_ST(0, wq[0]); ER_LD(2, wq[0]); asm volatile("" ::: "memory");
            ER_ST(1, wq[1]); ER_LD(3, wq[1]); asm volatile("" ::: "memory");
            ER_ST(2, wq[0]); asm volatile("" ::: "memory");
            ER_ST(3, wq[1]);
#undef ER_OFF
#undef ER_LD
#undef ER_ST
            return;
        }
#pragma unroll
        for (int ai = 0; ai < 2; ++ai)
#pragma unroll
            for (int m = 0; m < 4; ++m) { const size_t off = (size_t)(row0 + ai * HALF + m * 16) * 1024 + col0;
#pragma unroll
                for (int bj = 0; bj < 2; ++bj) { f32x4 x0, x1;
                    if (src_bf) { const u32x4 w = *(const u32x4*)((const bf16_t*)src + off + bj * HALF);
                        x0 = (f32x4){__uint_as_float(w.x << 16), __uint_as_float(w.x & 0xffff0000u), __uint_as_float(w.y << 16), __uint_as_float(w.y & 0xffff0000u)};
                        x1 = (f32x4){__uint_as_float(w.z << 16), __uint_as_float(w.z & 0xffff0000u), __uint_as_float(w.w << 16), __uint_as_float(w.w & 0xffff0000u)}; }
                    else { x0 = *(const f32x4*)((const float*)src + off + bj * HALF); x1 = *(const f32x4*)((const float*)src + off + bj * HALF + 4); }
                    const f32x4 y0 = x0 + cv[bj][0] * acc[ai][bj][m][0], y1 = x1 + cv[bj][1] * acc[ai][bj][m][1];
                    u32x4 o; o.x = cvt_pk_bf16(y0[0], y0[1]); o.y = cvt_pk_bf16(y0[2], y0[3]); o.z = cvt_pk_bf16(y1[0], y1[1]); o.w = cvt_pk_bf16(y1[2], y1[3]);
                    *(u32x4*)(dst + off + bj * HALF) = o; }
                if (m & 1) asm volatile("" ::: "memory"); }
    }
};
constexpr float SWG_C = -1.702f * 1.4426950408889634f;
__device__ __forceinline__ f32x2 swiglu_pk(f32x2 tg, f32x2 uq) {
    tg.x = fmaxf(tg.x, 7.0f * SWG_C); tg.y = fmaxf(tg.y, 7.0f * SWG_C); uq.x = __builtin_amdgcn_fmed3f(uq.x, 32.0f / SWG_C, -24.0f / SWG_C); uq.y = __builtin_amdgcn_fmed3f(uq.y, 32.0f / SWG_C, -24.0f / SWG_C);
    f32x2 d; d.x = __builtin_amdgcn_exp2f(tg.x); d.y = __builtin_amdgcn_exp2f(tg.y); d = d + 1.0f;
    f32x2 r; r.x = __builtin_amdgcn_rcpf(d.x); r.y = __builtin_amdgcn_rcpf(d.y);
    return (tg * r) * uq;
}
__device__ __forceinline__ unsigned pk4_fp8_raw(f32x2 a, f32x2 b) { int w; asm volatile("v_mov_b32 %0, 0" : "=v"(w)); w = __builtin_amdgcn_cvt_pk_fp8_f32(a.x, a.y, w, false); w = __builtin_amdgcn_cvt_pk_fp8_f32(b.x, b.y, w, true); return (unsigned)w; }
struct EpiSwiglu {
    static constexpr int PERM = 1;
    unsigned char* act; float s;
    __device__ __forceinline__ void operator()(const f32x4 (&acc)[2][2][4][2], const Unit& u, int wr, int wc, int fr, int fq, PG8_LAS unsigned char* ldsx, int buf) const {
        const int row0 = u.pm * BM + wr * 64 + fr, colh = u.pn * HALF + wc * 32 + 8 * fq;
        const PG8_LAS float* bb = (const PG8_LAS float*)(ldsx + 6144 + buf * 1024) + wc * 32 + 8 * fq;
        const float sg = s * SWG_C, su = s * (FP8_SA / SWG_C);
        const f32x4 bg0 = *(const PG8_LAS f32x4*)(bb) * SWG_C, bg1 = *(const PG8_LAS f32x4*)(bb + 4) * SWG_C, bu0 = (*(const PG8_LAS f32x4*)(bb + 128) + 1.0f) * (FP8_SA / SWG_C), bu1 = (*(const PG8_LAS f32x4*)(bb + 132) + 1.0f) * (FP8_SA / SWG_C);
        static_assert(FP8_SA == 4.0f, "swiglu_pk folds the activation scale 4");
        const int fqe = fq & ~1, rsel = fq & 1;
#pragma unroll
        for (int ai = 0; ai < 2; ++ai)
#pragma unroll
            for (int mp = 0; mp < 2; ++mp) {
                u32x2 w[2];
#pragma unroll
                for (int mm = 0; mm < 2; ++mm) { const int m = 2 * mp + mm;
                    const f32x4 g0 = acc[ai][0][m][0] * sg + bg0, g1 = acc[ai][0][m][1] * sg + bg1, u0 = acc[ai][1][m][0] * su + bu0, u1 = acc[ai][1][m][1] * su + bu1;
                    w[mm].x = pk4_fp8_raw(swiglu_pk((f32x2){g0[0], g0[1]}, (f32x2){u0[0], u0[1]}), swiglu_pk((f32x2){g0[2], g0[3]}, (f32x2){u0[2], u0[3]}));
                    w[mm].y = pk4_fp8_raw(swiglu_pk((f32x2){g1[0], g1[1]}, (f32x2){u1[0], u1[1]}), swiglu_pk((f32x2){g1[2], g1[3]}, (f32x2){u1[2], u1[3]})); }
                const auto rx = __builtin_amdgcn_permlane16_swap(w[0].x, w[1].x, false, false); const auto ry = __builtin_amdgcn_permlane16_swap(w[0].y, w[1].y, false, false);
                u32x4 o; o.x = rx[0]; o.y = ry[0]; o.z = rx[1]; o.w = ry[1];
                *(u32x4*)(act + (size_t)(row0 + ai * HALF + (2 * mp + rsel) * 16) * 1024 + u.pn * HALF + wc * 32 + 8 * fqe) = o; }
    }
};
constexpr float YS_SCALE = 16.0f;
struct EpiScatter {
    static constexpr int PERM = 2;
    unsigned char* ys; float s;
    __device__ __forceinline__ void operator()(const f32x4 (&acc)[2][2][4][2], const Unit& u, int wr, int wc, int fr, int fq, PG8_LAS unsigned char* ldsx, int buf) const {
        const PG8_LAS int* ip = (const PG8_LAS int*)(ldsx + buf * 1024); const PG8_LAS float* ig = (const PG8_LAS float*)(ldsx + 3072 + buf * 1024);
        const int cl = wc * 64 + 16 * fq; const PG8_LAS float* bb = (const PG8_LAS float*)(ldsx + 6144 + buf * 1024) + cl;
#pragma unroll
        for (int ai = 0; ai < 2; ++ai)
#pragma unroll
            for (int m = 0; m < 4; ++m) { const int rr = ai * HALF + wr * 64 + m * 16 + fr; const int pair = ip[rr]; const float gate = ig[rr] * YS_SCALE;
                u32x4 w;
#pragma unroll
                for (int bj = 0; bj < 2; ++bj)
#pragma unroll
                    for (int n = 0; n < 2; ++n) { const f32x4 bvv = *(const PG8_LAS f32x4*)(bb + 8 * bj + 4 * n); const f32x4 v = (acc[ai][bj][m][n] * s + bvv) * gate; w[bj * 2 + n] = pk4_fp8(v[0], v[1], v[2], v[3]); }
                const unsigned off = (unsigned)pair * 1024u + (unsigned)(u.pn * BM + cl);
                asm volatile("global_store_dwordx4 %0, %1, %2" :: "v"(off), "v"(w), "s"(ys) : "memory"); }
    }
};

__device__ __forceinline__ void glds16s(unsigned voff, const char* base, unsigned ldsaddr) { unsigned keep;
    asm volatile("s_mov_b32 %0, m0\n\ts_mov_b32 m0, %3\n\ts_nop 0\n\tglobal_load_lds_dwordx4 %1, %2\n\ts_mov_b32 m0, %0" : "=&s"(keep) : "v"(voff), "s"(base), "s"(ldsaddr) : "memory"); }
template <class Epi, class Sched, bool ALIGN_EPI, bool FP8>
__device__ __forceinline__ void gemm_phase(PG8_LAS unsigned char* lds, PG8_LAS unsigned char* ldsx, const int nt, const int ldaB, const int ldbB, const Sched& S, const Epi& E) {
    int tid = threadIdx.x; asm volatile("" : "+v"(tid));
    const int wid = __builtin_amdgcn_readfirstlane(tid >> 6), lane = tid & 63, wr = wid >> 2, wc = wid & 3, fr = lane & 15, fq = lane >> 4;
    int R0, C0; stage_rc(tid * 16, R0, C0);
    unsigned vA[2][2], voffB[2];
#pragma unroll
    for (int i = 0; i < 2; ++i) { const int R = R0 + 64 * i;
        const int Rb = (Epi::PERM == 1) ? ((R & ~31) + perm32(R & 31)) : (Epi::PERM == 2) ? (64 * (R >> 5) + 16 * ((R & 15) >> 2) + 4 * ((R >> 4) & 1) + (R & 3)) : R;
        voffB[i] = (unsigned)(Rb * ldbB + C0 * 2); vA[0][i] = (unsigned)(R * ldaB + C0 * 2); vA[1][i] = (unsigned)((R + HALF) * ldaB + C0 * 2); }
    const size_t kstep = (size_t)(BK * 2);
    constexpr int H1 = (Sched::GATHER_A || Sched::ROWOFF_A) ? 1 : 0;
    const size_t hstepA = (Sched::GATHER_A || Sched::ROWOFF_A) ? (size_t)0 : (size_t)HALF * ldaB;
    const size_t hstepB = (size_t)(Epi::PERM == 2 ? 8 : HALF) * ldbB;
    const unsigned lds32 = (unsigned)(__UINTPTR_TYPE__)lds + (unsigned)wid * 1024u;
    const int aoff = lds_byte(wr * 64 + fr, fq * 8), boff = lds_byte(wc * 32 + fr, fq * 8);
#define PG8_SA(b, h) (((b) * 2 + (h)) * HTB)
#define PG8_SB(b, h) ((4 + (b) * 2 + (h)) * HTB)
#define PG8_STAGE(bufoff, gbase, voff) do { _Pragma("unroll") for (int _i = 0; _i < 2; ++_i) glds16s((voff)[_i], (const char*)(gbase), lds32 + (unsigned)((bufoff) + _i * 8192)); } while (0)
#define PG8_LD8(p) __builtin_shufflevector(*(const PG8_LAS v4i*)(p), *(const PG8_LAS v4i*)((p) + 1024), 0, 1, 2, 3, 4, 5, 6, 7)
#define PG8_LDA(dst, b, h) do { if constexpr (FP8) { _Pragma("unroll") for (int m = 0; m < 4; ++m) dst##8[m] = PG8_LD8(lds + PG8_SA(b, h) + aoff + m * 2048); } \
        else { _Pragma("unroll") for (int m = 0; m < 4; ++m) _Pragma("unroll") for (int k = 0; k < 2; ++k) dst[m][k] = *(const PG8_LAS bf16x8*)(lds + PG8_SA(b, h) + aoff + m * 2048 + k * 1024); } } while (0)
#define PG8_LDB(dst, b, h) do { if constexpr (FP8) { _Pragma("unroll") for (int n = 0; n < 2; ++n) dst##8[n] = PG8_LD8(lds + PG8_SB(b, h) + boff + n * 2048); } \
        else { _Pragma("unroll") for (int n = 0; n < 2; ++n) _Pragma("unroll") for (int k = 0; k < 2; ++k) dst[n][k] = *(const PG8_LAS bf16x8*)(lds + PG8_SB(b, h) + boff + n * 2048 + k * 1024); } } while (0)
#define PG8_MMA(ai, bj, At, Bt) do { __builtin_amdgcn_s_setprio(1); \
        if constexpr (FP8) { _Pragma("unroll") for (int m = 0; m < 4; ++m) _Pragma("unroll") for (int n = 0; n < 2; ++n) \
            acc[ai][bj][m][n] = __builtin_amdgcn_mfma_scale_f32_16x16x128_f8f6f4(Bt##8[n], At##8[m], acc[ai][bj][m][n], 0, 0, 0, 0, 0, 0); } \
        else { _Pragma("unroll") for (int m = 0; m < 4; ++m) _Pragma("unroll") for (int n = 0; n < 2; ++n) _Pragma("unroll") for (int k = 0; k < 2; ++k) \
            acc[ai][bj][m][n] = __builtin_amdgcn_mfma_f32_16x16x32_bf16(Bt[n][k], At[m][k], acc[ai][bj][m][n], 0, 0, 0); } \
        __builtin_amdgcn_s_setprio(0); } while (0)
#define PG8_WAIT_V(n) asm volatile("s_waitcnt vmcnt(" #n ")" ::: "memory")
#define PG8_WAIT_L(n) asm volatile("s_waitcnt lgkmcnt(" #n ")" ::: "memory")
#define PG8_BAR __builtin_amdgcn_s_barrier()
#define PG8_SCHED __builtin_amdgcn_sched_barrier(0)
#define PG8_GATHER(dst, buf) do { const PG8_LAS int* _ip = (const PG8_LAS int*)(ldsx + (buf) * 1024); _Pragma("unroll") for (int _h = 0; _h < 2; ++_h) _Pragma("unroll") for (int _i = 0; _i < 2; ++_i) \
        dst[_h][_i] = (unsigned)(_ip[_h * HALF + R0 + 64 * _i] >> 2) * (unsigned)ldaB + (unsigned)(C0 * 2); } while (0)
#define PG8_ROWOFF(dst, pmv) do { _Pragma("unroll") for (int _h = 0; _h < 2; ++_h) _Pragma("unroll") for (int _i = 0; _i < 2; ++_i) \
        dst[_h][_i] = (unsigned)((pmv) * BM + _h * HALF + R0 + 64 * _i) * (unsigned)ldaB + (unsigned)(C0 * 2); } while (0)
    Unit cur, nxt; int ui = 0, bcur = 0;
    if (!S.next(0, cur)) return;
    f32x4 acc[2][2][4][2];
#pragma unroll
    for (int a = 0; a < 2; ++a)
#pragma unroll
        for (int b = 0; b < 2; ++b)
#pragma unroll
            for (int m = 0; m < 4; ++m)
#pragma unroll
                for (int n = 0; n < 2; ++n) acc[a][b][m][n] = zero4();
    bf16x8 At[4][2], B0[2][2], B1[2][2]; v8i At8[4], B08[2], B18[2];
    const char* cA; const char* cB; S.ptrs(cur, cA, cB);
    const int kmask = nt - 1;
#define PG8_K0(u) (((Sched::IDX ? (u).e : (u).pm) + 2 * (u).pn) & kmask)
    int k0 = PG8_K0(cur);
    if constexpr (Sched::IDX) {
        S.issue_idx(cur, ldsx, 0, wid, lane);
        PG8_STAGE(PG8_SB(0, 0), cB + (size_t)k0 * kstep, voffB); PG8_STAGE(PG8_SB(0, 1), cB + hstepB + (size_t)k0 * kstep, voffB);
        PG8_WAIT_V(4); PG8_BAR; asm volatile("" ::: "memory");
        if constexpr (Sched::GATHER_A) { PG8_GATHER(vA, 0); PG8_WAIT_L(0); }
    }
    if constexpr (Sched::ROWOFF_A) { PG8_ROWOFF(vA, cur.pm); }
    { const size_t o0 = (size_t)k0 * kstep, o1 = (size_t)((k0 + 1) & kmask) * kstep;
    if constexpr (!Sched::IDX) { PG8_STAGE(PG8_SB(0, 0), cB + o0, voffB); PG8_STAGE(PG8_SB(0, 1), cB + hstepB + o0, voffB); }
    PG8_STAGE(PG8_SA(0, 0), cA + o0, vA[0]); PG8_STAGE(PG8_SA(0, 1), cA + hstepA + o0, vA[H1]);
    if (wr == 1) PG8_BAR;
    PG8_WAIT_V(2); PG8_BAR;
    PG8_STAGE(PG8_SB(1, 0), cB + o1, voffB); PG8_STAGE(PG8_SA(1, 0), cA + o1, vA[0]); PG8_STAGE(PG8_SB(1, 1), cB + hstepB + o1, voffB);
    PG8_WAIT_V(6); PG8_BAR; }
#pragma unroll 1
    for (;;) {
        const bool has_next = S.next(ui + 1, nxt);
        const int bnxt = (bcur == 2) ? 0 : bcur + 1;
        const char* nA = cA; const char* nB = cB;
        int k0n = k0;
        if (has_next) { S.ptrs(nxt, nA, nB); k0n = PG8_K0(nxt); if constexpr (Sched::IDX) S.issue_idx(nxt, ldsx, bnxt, wid, lane); }
#pragma unroll 1
        for (int t = 0; t < nt; t += 2) {
            const bool last = (t == nt - 2);
            const char* a1 = cA + (size_t)((t + 1 + k0) & kmask) * kstep;
            const size_t o2 = (size_t)((last ? k0n : t + 2 + k0) & kmask) * kstep, o3 = (size_t)((last ? k0n + 1 : t + 3 + k0) & kmask) * kstep;
            const char* a2 = (last ? nA : cA) + o2; const char* b2 = (last ? nB : cB) + o2;
            const char* a3 = (last ? nA : cA) + o3; const char* b3 = (last ? nB : cB) + o3;
            PG8_LDB(B0, 0, 0); PG8_LDB(B1, 0, 1); PG8_SCHED; PG8_LDA(At, 0, 0); PG8_STAGE(PG8_SA(1, 1), a1 + hstepA, vA[H1]);
            if constexpr (Sched::GATHER_A) { if (last && has_next) { PG8_GATHER(vA, bnxt); } }
            if constexpr (Sched::ROWOFF_A) { if (last && has_next) { PG8_ROWOFF(vA, nxt.pm); } }
            PG8_WAIT_V(8); PG8_WAIT_L(0); PG8_BAR; PG8_MMA(0, 0, At, B0); PG8_MMA(0, 1, At, B1); PG8_BAR; PG8_SCHED;
            PG8_LDA(At, 0, 1); PG8_STAGE(PG8_SB(0, 0), b2, voffB); PG8_STAGE(PG8_SB(0, 1), b2 + hstepB, voffB); PG8_STAGE(PG8_SA(0, 0), a2, vA[0]);
            PG8_WAIT_V(8); PG8_WAIT_L(0); PG8_BAR; PG8_MMA(1, 0, At, B0); PG8_MMA(1, 1, At, B1); PG8_BAR; PG8_SCHED;
            PG8_LDB(B0, 1, 0); PG8_LDB(B1, 1, 1); PG8_SCHED; PG8_LDA(At, 1, 0); PG8_STAGE(PG8_SA(0, 1), a2 + hstepA, vA[H1]);
            PG8_WAIT_V(8); PG8_WAIT_L(0); PG8_BAR; PG8_MMA(0, 0, At, B0); PG8_MMA(0, 1, At, B1); PG8_BAR; PG8_SCHED;
            PG8_LDA(At, 1, 1); PG8_STAGE(PG8_SB(1, 0), b3, voffB); PG8_STAGE(PG8_SB(1, 1), b3 + hstepB, voffB); PG8_STAGE(PG8_SA(1, 0), a3, vA[0]);
            PG8_WAIT_V(8); PG8_WAIT_L(0); PG8_BAR; PG8_MMA(1, 0, At, B0); PG8_MMA(1, 1, At, B1); PG8_BAR; PG8_SCHED;
        }
        if constexpr (ALIGN_EPI) { if (wr == 0) PG8_BAR; }
        { int tz = threadIdx.x; asm volatile("" : "+v"(tz));
          const int wid2 = __builtin_amdgcn_readfirstlane(tz >> 6), lane2 = tz & 63; E(acc, cur, wid2 >> 2, wid2 & 3, lane2 & 15, lane2 >> 4, ldsx, bcur); }
        if (!has_next) break;
#pragma unroll
        for (int a = 0; a < 2; ++a)
#pragma unroll
            for (int b = 0; b < 2; ++b)
#pragma unroll
                for (int m = 0; m < 4; ++m)
#pragma unroll
                    for (int n = 0; n < 2; ++n) acc[a][b][m][n] = zero4();
        cur = nxt; cA = nA; cB = nB; ++ui; bcur = bnxt; k0 = k0n;
        if constexpr (ALIGN_EPI) { if (wr == 1) PG8_BAR; }
    }
    PG8_WAIT_V(0);
    if constexpr (!ALIGN_EPI) { if (wr == 0) PG8_BAR; }
    PG8_BAR;
#undef PG8_SA
#undef PG8_SB
#undef PG8_STAGE
#undef PG8_LDA
#undef PG8_LDB
#undef PG8_MMA
#undef PG8_LD8
#undef PG8_WAIT_V
#undef PG8_WAIT_L
#undef PG8_BAR
#undef PG8_SCHED
#undef PG8_GATHER
#undef PG8_ROWOFF
#undef PG8_K0
}
}
#include <hip/hip_bf16.h>
#include <cmath>
namespace attn_body {
using bf16=__hip_bfloat16;
using bf16x8=__attribute__((ext_vector_type(8)))short;
using s16x4=__attribute__((ext_vector_type(4)))short;
using f32x16=__attribute__((ext_vector_type(16)))float;
using u32x4=__attribute__((ext_vector_type(4)))unsigned;
typedef float f32x4v __attribute__((ext_vector_type(4)));
constexpr int BATCH=4,NHEAD=16,SEQ=8192,D=64,DM=NHEAD*D;
constexpr int NW=8,QBLK=32,QB=QBLK*NW,KVBLK=64,NQB=SEQ/QB;
constexpr int ATTN_PITCH=DM, ATTN_UNIT_ROWS=QB;
__device__ __forceinline__ int crow(int r,int hi){return (r&3)+8*(r>>2)+4*hi;}
#define SBAR() __builtin_amdgcn_sched_barrier(0)
__device__ __forceinline__ void cmask(f32x16&p0,f32x16&p1,int jb,int qrel,int hi){
  const float NEG=-INFINITY; int kb=64*jb+4*hi;
  #pragma unroll
  for(int r=0;r<16;++r){int kv=kb+(r&3)+8*(r>>2); if(kv>qrel)p0[r]=NEG; if(kv+32>qrel)p1[r]=NEG;}
}

constexpr int NSLOT=3, SLOTB=8192;
constexpr int LDS_K=0, LDS_V=NSLOT*SLOTB, LDS_WS=2*NSLOT*SLOTB, LDS_OST=LDS_WS+NW*64*4, LDS_FB=LDS_OST+NW*4096, LDS_BYTES=LDS_FB+NW*1024;
constexpr float O_SCALE=16.0f;
constexpr float C2=0.125f*1.4426950408889634f;
__device__ __forceinline__ void glds16(const void*gsrc,unsigned lds_dst){unsigned keep;
  asm volatile("s_mov_b32 %0, m0\n\ts_mov_b32 m0, %2\n\ts_nop 0\n\tglobal_load_lds_dwordx4 %1, off\n\ts_mov_b32 m0, %0":"=&s"(keep):"v"(gsrc),"s"(lds_dst):"memory");}
__device__ __forceinline__ void glds4(const void*gsrc,unsigned lds_dst){unsigned keep;
  asm volatile("s_mov_b32 %0, m0\n\ts_mov_b32 m0, %2\n\ts_nop 0\n\tglobal_load_lds_dword %1, off\n\ts_mov_b32 m0, %0":"=&s"(keep):"v"(gsrc),"s"(lds_dst):"memory");}
__device__ __forceinline__ float max3f(float a,float b,float c){float r;asm("v_max3_f32 %0, %1, %2, %3":"=v"(r):"v"(a),"v"(b),"v"(c));return r;}
__device__ __forceinline__ float max2f(float a,float b){float r;asm("v_max_f32_e32 %0, %1, %2":"=v"(r):"v"(a),"v"(b));return r;}
__device__ __forceinline__ float fadd_s(float a,float b){float r;asm("v_add_f32_e32 %0, %1, %2":"=v"(r):"v"(a),"v"(b));return r;}
__device__ __forceinline__ float fsub_s(float a,float b){float r;asm("v_sub_f32_e32 %0, %1, %2":"=v"(r):"v"(a),"v"(b));return r;}
typedef float f32x2_t __attribute__((ext_vector_type(2))); typedef __bf16 bf16x2_t __attribute__((ext_vector_type(2)));
__device__ __forceinline__ unsigned cvtpk_s(float lo,float hi){f32x2_t v={lo,hi};bf16x2_t b=__builtin_convertvector(v,bf16x2_t);return __builtin_bit_cast(unsigned,b);}
#define WAIT_BAR(N) asm volatile("s_waitcnt vmcnt(" #N ") lgkmcnt(0)\n\ts_barrier":::"memory")

__device__ __forceinline__ void qkt(f32x16&p0,f32x16&p1,const char*Kslot,const bf16x8*qr,int r32,int hi){ const f32x16 negm=f32x16{};
  const char*kb=Kslot+hi*1024+r32*16;
  #pragma unroll
  for(int d0=0;d0<4;++d0){
    const bf16x8 b0=*reinterpret_cast<const bf16x8*>(kb+d0*2048);
    const bf16x8 b1=*reinterpret_cast<const bf16x8*>(kb+d0*2048+512);
    if(d0==0){p0=__builtin_amdgcn_mfma_f32_32x32x16_bf16(b0,qr[0],negm,0,0,0);p1=__builtin_amdgcn_mfma_f32_32x32x16_bf16(b1,qr[0],negm,0,0,0);}
    else{p0=__builtin_amdgcn_mfma_f32_32x32x16_bf16(b0,qr[d0],p0,0,0,0);p1=__builtin_amdgcn_mfma_f32_32x32x16_bf16(b1,qr[d0],p1,0,0,0);}}
}
typedef __attribute__((address_space(3))) const char* lds_cptr;
typedef short v4i16_t __attribute__((ext_vector_type(4)));
__device__ __forceinline__ void kload8(bf16x8*kf,lds_cptr kp){
  kf[0]=*(const __attribute__((address_space(3))) bf16x8*)(kp);      kf[1]=*(const __attribute__((address_space(3))) bf16x8*)(kp+512);
  kf[2]=*(const __attribute__((address_space(3))) bf16x8*)(kp+2048); kf[3]=*(const __attribute__((address_space(3))) bf16x8*)(kp+2560);
  kf[4]=*(const __attribute__((address_space(3))) bf16x8*)(kp+4096); kf[5]=*(const __attribute__((address_space(3))) bf16x8*)(kp+4608);
  kf[6]=*(const __attribute__((address_space(3))) bf16x8*)(kp+6144); kf[7]=*(const __attribute__((address_space(3))) bf16x8*)(kp+6656);
}
__device__ __forceinline__ void kload2(bf16x8*kf,lds_cptr kp,int j){ kf[2*j]=*(const __attribute__((address_space(3))) bf16x8*)(kp+j*2048); kf[2*j+1]=*(const __attribute__((address_space(3))) bf16x8*)(kp+j*2048+512); }
__device__ __forceinline__ s16x4 vtr(lds_cptr p){ return __builtin_bit_cast(s16x4,__builtin_amdgcn_ds_read_tr16_b64_v4i16((__attribute__((address_space(3))) v4i16_t*)p)); }
__device__ __forceinline__ float rowmax(const f32x16&p0,const f32x16&p1){
  float a=max3f(p0[0],p0[1],p1[0]),b=max3f(p0[2],p0[3],p1[1]);a=max3f(a,p1[2],p1[3]);
  #pragma unroll
  for(int r=4;r<16;r+=4){a=max3f(a,p0[r],p0[r+1]);b=max3f(b,p0[r+2],p0[r+3]);a=max3f(a,p1[r],p1[r+1]);b=max3f(b,p1[r+2],p1[r+3]);}
  const float m=max2f(a,b);
  auto rr=__builtin_amdgcn_permlane32_swap(__float_as_uint(m),__float_as_uint(m),false,false);
  return max2f(__uint_as_float(rr[0]),__uint_as_float(rr[1]));
}
__device__ __forceinline__ void pv(f32x16*o,int vb,bf16x8 pa0,bf16x8 pa1,bf16x8 pa2,bf16x8 pa3){
  #pragma unroll
  for(int d0=0;d0<2;++d0){s16x4 lo[4],hi[4];
    #pragma unroll
    for(int ks=0;ks<4;++ks){
      asm volatile("ds_read_b64_tr_b16 %0,%1 offset:%c2":"=&v"(lo[ks]):"v"(vb),"i"(d0*4096+ks*1024):"memory");
      asm volatile("ds_read_b64_tr_b16 %0,%1 offset:%c2":"=&v"(hi[ks]):"v"(vb),"i"(d0*4096+ks*1024+512):"memory");}
    asm volatile("s_waitcnt lgkmcnt(0)":::"memory");SBAR();
    #define PK(k) (bf16x8){lo[k][0],lo[k][1],lo[k][2],lo[k][3],hi[k][0],hi[k][1],hi[k][2],hi[k][3]}
    o[d0]=__builtin_amdgcn_mfma_f32_32x32x16_bf16(pa0,PK(0),o[d0],0,0,0);
    o[d0]=__builtin_amdgcn_mfma_f32_32x32x16_bf16(pa1,PK(1),o[d0],0,0,0);
    o[d0]=__builtin_amdgcn_mfma_f32_32x32x16_bf16(pa2,PK(2),o[d0],0,0,0);
    o[d0]=__builtin_amdgcn_mfma_f32_32x32x16_bf16(pa3,PK(3),o[d0],0,0,0);
    #undef PK
  }
}

__device__ __forceinline__ int attn_j0(int b,int h,int qb,const float*__restrict__ FB,const unsigned*__restrict__ QN2,const unsigned*__restrict__ KN2,int lane){
  const int q0=qb*QB; const float* FBs=FB+((long)b*NHEAD+h)*SEQ; const int NT0=(q0+QB)/KVBLK;
  const unsigned*qp_=QN2+((b*NHEAD+h)*NQB+qb)*2,*kp_=KN2+(b*NHEAD+h)*2;
  const float qn=sqrtf(__uint_as_float(qp_[0])+__uint_as_float(qp_[1])), kn=sqrtf(__uint_as_float(kp_[0])+__uint_as_float(kp_[1]));
  const float thr=2.0f*qn*kn*1.02f+40.0f, fq0=FBs[q0];
  const int ja=lane, jb2=lane+64;
  const bool sa=(ja<NT0)&&(fq0-FBs[ja*KVBLK+KVBLK-1]>thr), sb=(jb2<NT0)&&(fq0-FBs[jb2*KVBLK+KVBLK-1]>thr);
  int j0=__builtin_popcountll(__ballot(sa))+__builtin_popcountll(__ballot(sb)); j0&=~1; if(j0>NT0-4)j0=NT0-4; return j0;
}
#ifndef ATTN_STORE16
#define ATTN_STORE16(p,v) (*(u32x4*)(p)=(v))
#endif
template<int THRL> __device__ __forceinline__ void attn_unit(int b,int h,int qb,const bf16*Q,const bf16*__restrict__ K,const bf16*__restrict__ V,bf16*O,const float*__restrict__ FB,int j0_in,char*shm,
                                                             bool pre,bool has_next,int nb,int nh,int nqb,int nj0,bf16x8 (&qr)[4]){
  int tid=threadIdx.x; asm volatile("":"+v"(tid)); const int lane=tid&63,r32=lane&31,hi=lane>>5; const int wid=__builtin_amdgcn_readfirstlane(tid>>6);
  const long rowbase=(long)b*SEQ; const int q0=qb*QB;
  const bf16*Qw=Q+(rowbase+q0+wid*QBLK)*DM+h*D;
  const int j0=j0_in;
  const bf16*Kh=K+(rowbase+(long)j0*KVBLK)*DM+h*D,*Vh=V+(rowbase+(long)j0*KVBLK)*DM+h*D;
  const unsigned lds0=(unsigned)(uintptr_t)shm;
  float*wsf=(float*)(shm+LDS_WS)+wid*64;
  const bf16*ksrc=Kh+(long)lane*DM+wid*8;
  const bf16*vsrc=Vh+(long)(16*(wid&3)+(lane>>2))*DM+(wid>>2)*32+(lane&3)*8;
  const unsigned kdst=lds0+LDS_K+wid*1024, vdst=lds0+LDS_V+wid*1024;
  const float*fbsrc=FB+((long)b*NHEAD+h)*SEQ+(long)j0*KVBLK+lane; const unsigned fbdst=lds0+LDS_FB+wid*1024;
  #define DMA_K(t,slot) do{ glds16(ksrc+(long)(t)*KVBLK*DM,(unsigned)__builtin_amdgcn_readfirstlane(kdst+(slot))); glds4(fbsrc+(long)(t)*KVBLK,(unsigned)__builtin_amdgcn_readfirstlane(fbdst+(((t)&3)<<8))); }while(0)
  #define DMA_V(t,slot) glds16(vsrc+(long)(t)*KVBLK*DM,(unsigned)__builtin_amdgcn_readfirstlane(vdst+(slot)))
  const int vb0=(int)(lds0+LDS_V)+((lane>>4)&1)*32+(lane&3)*8+(4*hi+((lane&15)>>2))*64;
  const char*Kbase=shm+LDS_K; bf16x8 kf[8];
  const lds_cptr shm3=(lds_cptr)shm; const lds_cptr kp0=shm3+LDS_K+hi*1024+r32*16; const lds_cptr vp0=shm3+LDS_V+((lane>>4)&1)*32+(lane&3)*8+(4*hi+((lane&15)>>2))*64;
  const int NT=(q0+QB)/KVBLK-j0;
  if(!pre){ DMA_K(0,0);DMA_V(0,0);DMA_K(1,SLOTB); }
  if(!pre){
    #pragma unroll
    for(int d0=0;d0<4;++d0)qr[d0]=*reinterpret_cast<const bf16x8*>(&Qw[(long)r32*DM+d0*16+hi*8]); }
  float mhat=0.f,l_reg=0.f;f32x16 o[2];
  _Pragma("unroll") for(int d_=0;d_<2;++d_) _Pragma("unroll") for(int r=0;r<16;++r){ float z_; asm volatile("v_mov_b32 %0, 0":"=v"(z_)); o[d_][r]=z_; }
  const int qrel=wid*QBLK+r32;
  #define CMASK(P0,P1,t) do{int jb_=(t)-(NT-4); if(jb_>=0)cmask(P0,P1,jb_,qrel,hi);}while(0)
  const unsigned hmask=hi?0u:0xffffffffu, c3f=0x3F803F80u&hmask;
  u32x4 mqw; mqw[0]=c3f; mqw[1]=0x3F80u&hmask; mqw[2]=0u; mqw[3]=0u;
  const __attribute__((address_space(3))) float* fbw=(const __attribute__((address_space(3))) float*)(shm3+LDS_FB+wid*1024)+r32;
  #define SETMQ() do{ const float nm_=-mhat; const unsigned u1_=__float_as_uint(nm_)&0xffff0000u; const float q1_=nm_-__uint_as_float(u1_); const unsigned u2_=__float_as_uint(q1_)&0xffff0000u; \
      const float q2_=q1_-__uint_as_float(u2_); const unsigned u3_=__float_as_uint(q2_)&0xffff0000u; mqw[1]=(0x3F80u|u1_)&hmask; mqw[2]=((u2_>>16)|u3_)&hmask; }while(0)
  #define BFRAG(dst,bv) do{ const unsigned u1_=__float_as_uint(bv)&0xffff0000u; const float q1_=(bv)-__uint_as_float(u1_); const unsigned u2_=__float_as_uint(q1_)&0xffff0000u; \
      const float q2_=q1_-__uint_as_float(u2_); const unsigned u3_=__float_as_uint(q2_)>>16; dst[0]=((u1_>>16)|u2_)&hmask; dst[1]=(u3_|0x3F800000u)&hmask; dst[2]=c3f; dst[3]=0u; }while(0)
  #define KBIAS(P0,P1,t) do{ const float bq0_=fbw[(((t)&3)<<6)], bq1_=fbw[(((t)&3)<<6)+32]; u32x4 ba_; \
      BFRAG(ba_,bq0_); P0=__builtin_amdgcn_mfma_f32_32x32x16_bf16(__builtin_bit_cast(bf16x8,ba_),__builtin_bit_cast(bf16x8,mqw),P0,0,0,0); \
      BFRAG(ba_,bq1_); P1=__builtin_amdgcn_mfma_f32_32x32x16_bf16(__builtin_bit_cast(bf16x8,ba_),__builtin_bit_cast(bf16x8,mqw),P1,0,0,0); }while(0)
  bool resc=false;
  #define START(P0,P1) do{ const float rm=rowmax(P0,P1); resc=false; \
    { const float dl=rm; mhat=fadd_s(mhat,dl); \
      _Pragma("unroll") for(int r=0;r<16;++r){P0[r]=fsub_s(P0[r],dl);P1[r]=fsub_s(P1[r],dl);} \
      SETMQ(); } \
    _Pragma("unroll") for(int r=0;r<16;++r)P0[r]=__builtin_amdgcn_exp2f(P0[r]); }while(0)
  #define RESC() do{ if(resc){ asm volatile("s_waitcnt lgkmcnt(0)":::"memory"); \
      _Pragma("unroll") for(int d_=0;d_<2;++d_) _Pragma("unroll") for(int r=0;r<16;++r)o[d_][r]*=wsf[crow(r,hi)]; } }while(0)
  f32x16 pA0,pA1,pB0,pB1;
  int sl_prev=0,sl_cur=0,sl_next=SLOTB;
  #define ROT() do{sl_prev=sl_cur;sl_cur=sl_next;sl_next=(sl_next==(NSLOT-1)*SLOTB)?0:sl_next+SLOTB;}while(0)
  if(!pre){ DMA_K(2,2*SLOTB); }
  WAIT_BAR(5);
  qkt(pA0,pA1,Kbase,qr,r32,hi);KBIAS(pA0,pA1,0);asm volatile("s_nop 15\n\ts_nop 7":"+v"(pA0),"+v"(pA1));CMASK(pA0,pA1,0);
  START(pA0,pA1);
  _Pragma("unroll") for(int r=0;r<16;++r)pA1[r]=__builtin_amdgcn_exp2f(pA1[r]);
  WAIT_BAR(0);
  DMA_K(3,0);DMA_V(1,SLOTB);
  ROT();
  kload8(kf,kp0+sl_cur);
  WAIT_BAR(3);
  s16x4 vlo[8],vhi[8]; u32x4 pw0,pw1,pw2,pw3;
  #define PKW(P,B) cvtpk_s(P[B],P[B+1])
  #define PAF(k) __builtin_bit_cast(bf16x8,pw##k)
  #define VFR(i) (bf16x8){vlo[i][0],vlo[i][1],vlo[i][2],vlo[i][3],vhi[i][0],vhi[i][1],vhi[i][2],vhi[i][3]}
  #define PIN(x) asm volatile("":"+v"(x))
  #define MX3(a,b,c) __builtin_fmaxf(__builtin_fmaxf((a),(b)),(c))
  #define GAPA(MF,A0,A1,A2,A3,W0,W1,PW) do{ MF; sacc+=A0; sacc+=A1; sacc+=A2; sacc+=A3; PIN(sacc); W0; W1; PIN(PW); SBAR(); }while(0)
  #define EX(v) __builtin_amdgcn_exp2f(v)
  #define GAPB(MF,X,B) do{ MF; X[B]=EX(X[B]); X[B+1]=EX(X[B+1]); X[B+2]=EX(X[B+2]); X[B+3]=EX(X[B+3]); PIN(X); SBAR(); }while(0)
  #define VRD(i) do{ vlo[i]=vtr(vp_+(((i)>>2)*4096+((i)&3)*1024)); vhi[i]=vtr(vp_+(((i)>>2)*4096+((i)&3)*1024+512)); }while(0)
  #define KRD(G,j) do{ if(G){ kload2(kf,kp0+sl_next,j); SBAR(); } }while(0)
  #define STEP(C0,C1,P0,P1,t,GK,GV,GL) do{ SBAR(); \
    const lds_cptr vp_=vp0+sl_prev; \
    VRD(0); SBAR(); float sacc=(P0[0]+P0[1]); \
    GAPA(C0=__builtin_amdgcn_mfma_f32_32x32x16_bf16(kf[0],qr[0],f32x16{},0,0,0), P0[2],P0[3],P0[4],P0[5],     pw0[0]=PKW(P0,0), pw0[1]=PKW(P0,2), pw0); \
    VRD(4); SBAR(); GAPA(C1=__builtin_amdgcn_mfma_f32_32x32x16_bf16(kf[1],qr[0],f32x16{},0,0,0), P0[6],P0[7],P0[8],P0[9],     pw0[2]=PKW(P0,4), pw0[3]=PKW(P0,6), pw0); \
    VRD(1); SBAR(); GAPA(C0=__builtin_amdgcn_mfma_f32_32x32x16_bf16(kf[2],qr[1],C0,0,0,0),   P0[10],P0[11],P0[12],P0[13], pw1[0]=PKW(P0,8), pw1[1]=PKW(P0,10), pw1); \
    VRD(5); SBAR(); GAPA(C1=__builtin_amdgcn_mfma_f32_32x32x16_bf16(kf[3],qr[1],C1,0,0,0),   P0[14],P0[15],P1[0],P1[1],   pw1[2]=PKW(P0,12),pw1[3]=PKW(P0,14), pw1); \
    VRD(2); SBAR(); GAPA(C0=__builtin_amdgcn_mfma_f32_32x32x16_bf16(kf[4],qr[2],C0,0,0,0),   P1[2],P1[3],P1[4],P1[5],     pw2[0]=PKW(P1,0), pw2[1]=PKW(P1,2), pw2); \
    VRD(6); SBAR(); GAPA(C1=__builtin_amdgcn_mfma_f32_32x32x16_bf16(kf[5],qr[2],C1,0,0,0),   P1[6],P1[7],P1[8],P1[9],     pw2[2]=PKW(P1,4), pw2[3]=PKW(P1,6), pw2); \
    VRD(3); SBAR(); GAPA(C0=__builtin_amdgcn_mfma_f32_32x32x16_bf16(kf[6],qr[3],C0,0,0,0),   P1[10],P1[11],P1[12],P1[13], pw3[0]=PKW(P1,8), pw3[1]=PKW(P1,10), pw3); \
    VRD(7); SBAR(); GAPA(C1=__builtin_amdgcn_mfma_f32_32x32x16_bf16(kf[7],qr[3],C1,0,0,0),   P1[14],P1[15],0.f,0.f,       pw3[2]=PKW(P1,12),pw3[3]=PKW(P1,14), pw3); \
    KBIAS(C0,C1,t); SBAR(); l_reg+=sacc; \
    if(GK){DMA_K((t)+3,sl_cur);} if(GV){DMA_V((t)+1,sl_next);} \
    CMASK(C0,C1,t); \
    { float a=MX3(C0[0],C0[1],C1[0]),b=MX3(C0[2],C0[3],C1[1]); a=MX3(a,C1[2],C1[3]); \
      _Pragma("unroll") for(int r=4;r<16;r+=4){a=MX3(a,C0[r],C0[r+1]);b=MX3(b,C0[r+2],C0[r+3]);a=MX3(a,C1[r],C1[r+1]);b=MX3(b,C1[r+2],C1[r+3]);} \
      float rm=__builtin_fmaxf(a,b); { auto rr=__builtin_amdgcn_permlane32_swap(__float_as_uint(rm),__float_as_uint(rm),false,false); rm=__builtin_fmaxf(__uint_as_float(rr[0]),__uint_as_float(rr[1])); } \
      resc=false; \
      if(__builtin_expect(__any(rm>(float)THRL),0)){ const float dl=__builtin_fmaxf(rm,0.f); mhat+=dl; \
        _Pragma("unroll") for(int r=0;r<16;++r){C0[r]-=dl;C1[r]-=dl;} \
        SETMQ(); \
        const float f=__builtin_amdgcn_exp2f(-dl); l_reg*=f; if(hi==0)wsf[r32]=f; resc=true; } } \
    SBAR(); \
    GAPB(o[0]=__builtin_amdgcn_mfma_f32_32x32x16_bf16(PAF(0),VFR(0),o[0],0,0,0), C0,0); \
    GAPB(o[1]=__builtin_amdgcn_mfma_f32_32x32x16_bf16(PAF(0),VFR(4),o[1],0,0,0), C0,4); \
    KRD(GL,0); GAPB(o[0]=__builtin_amdgcn_mfma_f32_32x32x16_bf16(PAF(1),VFR(1),o[0],0,0,0), C0,8); \
    KRD(GL,1); GAPB(o[1]=__builtin_amdgcn_mfma_f32_32x32x16_bf16(PAF(1),VFR(5),o[1],0,0,0), C0,12); \
    KRD(GL,2); GAPB(o[0]=__builtin_amdgcn_mfma_f32_32x32x16_bf16(PAF(2),VFR(2),o[0],0,0,0), C1,0); \
    KRD(GL,3); GAPB(o[1]=__builtin_amdgcn_mfma_f32_32x32x16_bf16(PAF(2),VFR(6),o[1],0,0,0), C1,4); \
    GAPB(o[0]=__builtin_amdgcn_mfma_f32_32x32x16_bf16(PAF(3),VFR(3),o[0],0,0,0), C1,8); \
    GAPB(o[1]=__builtin_amdgcn_mfma_f32_32x32x16_bf16(PAF(3),VFR(7),o[1],0,0,0), C1,12); \
    }while(0)
  int t=1;
  #undef CMASK
  #define CMASK(P0,P1,t) do{}while(0)
  for(;t+5<NT;t+=2){
    STEP(pB0,pB1,pA0,pA1,t,true,true,true);     WAIT_BAR(3); RESC(); ROT();
    STEP(pA0,pA1,pB0,pB1,t+1,true,true,true);   WAIT_BAR(3); RESC(); ROT();
  }
  #undef CMASK
  #define CMASK(P0,P1,t) do{int jb_=(t)-(NT-4); if(jb_>=0)cmask(P0,P1,jb_,qrel,hi);}while(0)
  #define ENDW(tt) do{ if((tt)+3<NT){WAIT_BAR(3);} else if((tt)+2<NT){WAIT_BAR(1);} else {WAIT_BAR(0);} }while(0)
  for(;t+1<NT;t+=2){
    STEP(pB0,pB1,pA0,pA1,t,(t+3<NT),(t+1<NT),(t+1<NT));       ENDW(t);   RESC(); ROT();
    STEP(pA0,pA1,pB0,pB1,t+1,(t+4<NT),(t+2<NT),(t+2<NT));     ENDW(t+1); RESC(); ROT();
  }
  STEP(pB0,pB1,pA0,pA1,NT-1,false,false,false); RESC();
  { float sacc=pB0[0]+pB0[1]; _Pragma("unroll") for(int r=2;r<16;++r)sacc+=pB0[r]; _Pragma("unroll") for(int r=0;r<16;++r)sacc+=pB1[r]; l_reg+=sacc;
    pw0=(u32x4){PKW(pB0,0),PKW(pB0,2),PKW(pB0,4),PKW(pB0,6)};pw1=(u32x4){PKW(pB0,8),PKW(pB0,10),PKW(pB0,12),PKW(pB0,14)};pw2=(u32x4){PKW(pB1,0),PKW(pB1,2),PKW(pB1,4),PKW(pB1,6)};pw3=(u32x4){PKW(pB1,8),PKW(pB1,10),PKW(pB1,12),PKW(pB1,14)};
    SBAR(); pv(o,vb0+sl_cur,PAF(0),PAF(1),PAF(2),PAF(3)); }
  #undef PKW
  #undef PAF
  #undef VFR
  #undef PIN
  #undef MX3
  #undef GAPA
  #undef GAPB
  #undef EX
  #undef VRD
  #undef KRD
  #undef STEP
  #undef ENDW
  asm volatile("s_waitcnt lgkmcnt(0)\n\ts_barrier":::"memory");
  if(has_next){
    const long nrowbase=(long)nb*SEQ; const int nq0=nqb*QB;
    const bf16*nKh=K+(nrowbase+(long)nj0*KVBLK)*DM+nh*D,*nVh=V+(nrowbase+(long)nj0*KVBLK)*DM+nh*D;
    const bf16*nks=nKh+(long)lane*DM+wid*8; const bf16*nvs=nVh+(long)(16*(wid&3)+(lane>>2))*DM+(wid>>2)*32+(lane&3)*8;
    const float*nfb=FB+((long)nb*NHEAD+nh)*SEQ+(long)nj0*KVBLK+lane;
    #define NDMA_K(t,slot) do{ glds16(nks+(long)(t)*KVBLK*DM,(unsigned)__builtin_amdgcn_readfirstlane(kdst+(slot))); glds4(nfb+(long)(t)*KVBLK,(unsigned)__builtin_amdgcn_readfirstlane(fbdst+(((t)&3)<<8))); }while(0)
    NDMA_K(0,0); glds16(nvs,(unsigned)__builtin_amdgcn_readfirstlane(vdst)); NDMA_K(1,SLOTB); NDMA_K(2,2*SLOTB);
    #undef NDMA_K
    const bf16*nQw=Q+(nrowbase+nq0+wid*QBLK)*DM+nh*D;
    #pragma unroll
    for(int d0=0;d0<4;++d0)qr[d0]=*reinterpret_cast<const bf16x8*>(&nQw[(long)r32*DM+d0*16+hi*8]);
  }
  {auto rr=__builtin_amdgcn_permlane32_swap(__float_as_uint(l_reg),__float_as_uint(l_reg),false,false);l_reg=__uint_as_float(rr[0])+__uint_as_float(rr[1]);}
  if(hi==0)wsf[32+r32]=l_reg;asm volatile("s_waitcnt lgkmcnt(0)":::"memory");
  float rli[16];
  #pragma unroll
  for(int r=0;r<16;++r)rli[r]=__builtin_amdgcn_rcpf(wsf[32+crow(r,hi)]);
  unsigned char*Ow=(unsigned char*)O+(rowbase+q0+wid*QBLK)*DM+h*D;
  { unsigned char*stg=(unsigned char*)(shm+LDS_OST)+wid*4096;
    #pragma unroll
    for(int r=0;r<16;++r){const int orow=crow(r,hi); const float sc_=rli[r]*O_SCALE;
      #pragma unroll
      for(int d0=0;d0<2;++d0){ const float x_=__builtin_amdgcn_fmed3f(o[d0][r]*sc_,-448.0f,448.0f); int w_; asm volatile("v_mov_b32 %0, 0":"=v"(w_)); w_=__builtin_amdgcn_cvt_pk_fp8_f32(x_,x_,w_,false); stg[orow*64+d0*32+r32]=(unsigned char)w_; } }
    asm volatile("s_waitcnt lgkmcnt(0)":::"memory");
    #pragma unroll
    for(int i=0;i<2;++i){const int row=i*16+(lane>>2),ch=lane&3; const u32x4 v=*(const u32x4*)(stg+row*64+ch*16); ATTN_STORE16(Ow+(long)row*DM+ch*16,v);} }
  asm volatile("s_waitcnt lgkmcnt(0)":::"memory");
  #undef DMA_K
  #undef DMA_V
  #undef KBIAS
  #undef BFRAG
  #undef SETMQ
  #undef CMASK
  #undef START
  #undef RESC
  #undef ROT
}
constexpr int ATTN_LDS_BYTES=LDS_BYTES;
struct AttnTensors { const bf16* Q; const bf16* K; const bf16* V; bf16* O; const float* FB; const unsigned* QN2; const unsigned* KN2; };
struct AttnUnit { int bh; int qb; };
struct StaticOrder {
  int vcu;
  __device__ __forceinline__ explicit StaticOrder(int grid,int block):vcu((block%8)*(grid/8)+block/8){}
  __device__ __forceinline__ bool next(int i,AttnUnit&u)const{ if(i>=8)return false; const int x=vcu>>5,j=vcu&31; u.bh=8*x+i; u.qb=(j+4*i)&31; return true; }
  __device__ __forceinline__ void a_ready(const AttnUnit&)const{}
  __device__ __forceinline__ void done(const AttnUnit&)const{}
};
template<class Sched,int THRL=64> __device__ __forceinline__ void attn_phase(char*lds,const AttnTensors&T,const Sched&S,volatile __attribute__((address_space(3))) int*j0buf){
  AttnUnit u;
  { int tid=threadIdx.x; asm volatile("":"+v"(tid)); const int lane=tid&63,wid=__builtin_amdgcn_readfirstlane(tid>>6);
    if(S.next(wid,u)){ const int j=attn_j0(u.bh/NHEAD,u.bh%NHEAD,u.qb,T.FB,T.QN2,T.KN2,lane); if(lane==0)j0buf[wid]=j; }
    asm volatile("s_waitcnt lgkmcnt(0)\n\ts_barrier":::"memory"); }
  bf16x8 qr[4]; bool pre=false;
  #pragma unroll 1
  for(int i=0;S.next(i,u);++i){ S.a_ready(u); AttnUnit un; const bool hn=S.next(i+1,un); const int nj0=hn?__builtin_amdgcn_readfirstlane(j0buf[i+1]):0;
    attn_unit<THRL>(u.bh/NHEAD,u.bh%NHEAD,u.qb,T.Q,T.K,T.V,T.O,T.FB,__builtin_amdgcn_readfirstlane(j0buf[i]),lds,pre,hn,un.bh/NHEAD,un.bh%NHEAD,un.qb,nj0,qr); pre=hn; S.done(u); }
}
#undef SBAR
#undef WAIT_BAR
}
constexpr int NWAVES = 8;
constexpr size_t MiB = 1u << 20;
constexpr size_t WS_CTL = 0, CTL_ZERO_BYTES = 128 * 1024;
constexpr size_t WS_MODV = 1 * MiB;
constexpr size_t WS_R1 = 2 * MiB;
constexpr size_t WS_LF = 3 * MiB, WS_FB = 5 * MiB;
constexpr size_t WS_SLOTP = 8 * MiB, WS_SLOTG = 12 * MiB;
constexpr size_t WS_WPOOL = 16 * MiB, WS_WO = 18 * MiB, WS_WQKV = 22 * MiB;
constexpr size_t WS_HB = 64 * MiB;
constexpr size_t WS_Q = 128 * MiB, WS_K = 192 * MiB, WS_V = 256 * MiB;
constexpr size_t WS_YS = 320 * MiB;
constexpr size_t WS_ACT = 576 * MiB;
constexpr size_t WS_W2 = 848 * MiB, WS_W1 = 1104 * MiB;
constexpr size_t WS_XB = 1616 * MiB, WS_END = 1680 * MiB;
static_assert(WS_ACT + (size_t)MAXMT * 256 * 1024 * 2 <= WS_W2 && WS_W1 + (size_t)DEPTH * NEXP * 2048 * 1024 * 2 <= WS_XB && WS_XB + (size_t)T * D * 2 <= WS_END, "d_ws map");
constexpr int CW_TMO = 0, CW_CODE = 1, CW_BAR = 4096, CW_GCNT = 8192, CW_KN2 = 8448, CW_QN2 = 8704;
constexpr int RING_OFF = 0, RING_BYTES = 131072;
constexpr int IDX_OFF = RING_BYTES;
constexpr int SCHED_OFF = IDX_OFF + pg8::IDX_BYTES;
constexpr int MISC_OFF = SCHED_OFF + 1024;
constexpr int LDS_BYTES = 147456;
static_assert(MISC_OFF + 128 <= LDS_BYTES, "LDS map");

typedef unsigned short bf16;
typedef unsigned v4u __attribute__((ext_vector_type(4)));
typedef unsigned v2u __attribute__((ext_vector_type(2)));
typedef float f32x4 __attribute__((ext_vector_type(4)));
typedef GAS unsigned gu32;
#define RLX_AGENT __ATOMIC_RELAXED, __HIP_MEMORY_SCOPE_AGENT
#define LDS_WAIT() asm volatile("s_waitcnt lgkmcnt(0)" ::: "memory")
#define VM_WAIT() asm volatile("s_waitcnt vmcnt(0)" ::: "memory")
__device__ __forceinline__ unsigned f2bf(float f) { unsigned u = __builtin_bit_cast(unsigned, f); return (u + 0x7fffu + ((u >> 16) & 1u)) >> 16; }
__device__ __forceinline__ unsigned pk2(float lo, float hi) { return pg8::cvt_pk_bf16(lo, hi); }
__device__ __forceinline__ float bflo(unsigned u) { return __builtin_bit_cast(float, u << 16); }
__device__ __forceinline__ float bfhi(unsigned u) { return __builtin_bit_cast(float, u & 0xffff0000u); }
template <bool BF> __device__ __forceinline__ f32x4 ldx4(const void* base, size_t eoff) {
    if (BF) { const v2u w = *(const GAS v2u*)((const bf16*)base + eoff); return (f32x4){bflo(w.x), bfhi(w.x), bflo(w.y), bfhi(w.y)}; }
    return *(const GAS f32x4*)((const float*)base + eoff);
}
__device__ __forceinline__ void stx4_bf(bf16* base, size_t eoff, f32x4 v) { v2u o; o.x = pk2(v.x, v.y); o.y = pk2(v.z, v.w); *(GAS v2u*)(base + eoff) = o; }
#define XB_TMO      128
#define XB_XCNT(j)  (256  + 64 * (j))
#define XB_XSUB(j)  (1280 + 64 * (j))
#define XB_XGEN(j)  (2304 + 64 * (j))
#define XB_TOP      3328
#define XB_TOPGEN   3392
#define XCD_BAR_WORDS 3456
#define XB_SPIN_CAP (1u << 18)

__device__ __forceinline__ unsigned xb_ld(unsigned* p)              { return __hip_atomic_load(p, __ATOMIC_RELAXED, __HIP_MEMORY_SCOPE_AGENT); }
__device__ __forceinline__ unsigned xb_add(unsigned* p, unsigned v) { return __hip_atomic_fetch_add(p, v, __ATOMIC_RELAXED, __HIP_MEMORY_SCOPE_AGENT); }
__device__ __forceinline__ unsigned xb_xcc_id() { return (unsigned)__builtin_amdgcn_s_getreg((3 << 11) | 20) & 0xFu; }
#define XB_SPIN(cond, bar) do { unsigned _sp = 0; while (cond) { __builtin_amdgcn_s_sleep(1); \
    if ((++_sp & 255u) == 0u) { if (xb_ld(&(bar)[XB_TMO])) break; if (_sp > XB_SPIN_CAP) { atomicAdd(&(bar)[XB_TMO], 1u); break; } } } } while (0)

struct XcdBarrier {
    unsigned* bar; unsigned x;
    volatile LAS unsigned* st;
};

__device__ __forceinline__ XcdBarrier xcd_barrier_post(unsigned* bar, volatile LAS unsigned* st) {
    XcdBarrier b; b.bar = bar; b.x = xb_xcc_id(); b.st = st;
    if (threadIdx.x == 0) (void)xb_add(&bar[XB_XCNT(b.x)], 1u);
    return b;
}
__device__ __forceinline__ void xcd_barrier_complete(unsigned* bar, unsigned x, unsigned& nloc, unsigned& nx) {
    const unsigned G = gridDim.x * gridDim.y * gridDim.z;
    unsigned sum, cnt, mine, sp = 0u;
    for (;;) {
        sum = 0u; cnt = 0u; mine = 0u;
#pragma unroll
        for (unsigned j = 0; j < 16; ++j) { const unsigned c = xb_ld(&bar[XB_XCNT(j)]); sum += c; cnt += (c > 0u) ? 1u : 0u; mine = (j == x) ? c : mine; }
        if (sum == G) break;
        __builtin_amdgcn_s_sleep(1);
        if ((++sp & 255u) == 0u) { if (xb_ld(&bar[XB_TMO])) break; if (sp > XB_SPIN_CAP) { atomicAdd(&bar[XB_TMO], 1u); break; } }
    }
    nloc = mine > 0u ? mine : 1u; nx = cnt > 0u ? cnt : 1u;
}

__device__ __forceinline__ void xcd_barrier(const XcdBarrier& b) {
    asm volatile("s_waitcnt vmcnt(0)" ::: "memory");
    __syncthreads();
    if (threadIdx.x == 0) {
        unsigned* bar = b.bar;
        __builtin_amdgcn_s_waitcnt(0);
        unsigned nloc = b.st[0], nx = b.st[1];
        if (nloc == 0u) { xcd_barrier_complete(bar, b.x, nloc, nx); b.st[0] = nloc; b.st[1] = nx; }
        const unsigned old = xb_add(&bar[XB_XSUB(b.x)], 1u);
        const unsigned gen = old / nloc;
        if (old + 1u == (gen + 1u) * nloc) {
            __builtin_amdgcn_fence(__ATOMIC_RELEASE, "agent");
            asm volatile("s_waitcnt vmcnt(0)" ::: "memory");
            const unsigned og = xb_add(&bar[XB_TOP], 1u);
            const unsigned tg = og / nx;
            if (og + 1u == (tg + 1u) * nx) xb_add(&bar[XB_TOPGEN], 1u);
            else XB_SPIN(xb_ld(&bar[XB_TOPGEN]) == tg, bar);
            __builtin_amdgcn_fence(__ATOMIC_ACQUIRE, "agent");
            xb_add(&bar[XB_XGEN(b.x)], 1u);
            asm volatile("s_waitcnt vmcnt(0)" ::: "memory");
        } else {
            XB_SPIN(xb_ld(&bar[XB_XGEN(b.x)]) == gen, bar);
            __builtin_amdgcn_fence(__ATOMIC_ACQUIRE, "agent");
            asm volatile("s_waitcnt vmcnt(0)" ::: "memory");
        }
    }
    __syncthreads();
}
struct Frame {
    LAS unsigned char* lds;
    volatile LAS unsigned* MISC;
    gu32* ctl;
    int tid, lane, wave, G, bid;
};
template <int CTRL, int ROWMASK = 0xF> __device__ __forceinline__ float dppf(float v) { return __builtin_bit_cast(float, __builtin_amdgcn_update_dpp(0, __builtin_bit_cast(int, v), CTRL, ROWMASK, 0xF, false)); }
__device__ __forceinline__ float wave_sum(float v) {
    v += dppf<0xB1>(v); v += dppf<0x4E>(v); v += dppf<0x141>(v); v += dppf<0x140>(v);
    { const auto r = __builtin_amdgcn_permlane16_swap(__float_as_uint(v), __float_as_uint(v), false, false); v = __uint_as_float(r[0]) + __uint_as_float(r[1]); }
    { const auto r = __builtin_amdgcn_permlane32_swap(__float_as_uint(v), __float_as_uint(v), false, false); v = __uint_as_float(r[0]) + __uint_as_float(r[1]); }
    return v;
}
__device__ __forceinline__ float wave_incl_scan(float x) {
    x += dppf<0x111>(x); x += dppf<0x112>(x); x += dppf<0x114>(x); x += dppf<0x118>(x);
    x += dppf<0x142, 0xA>(x);
    x += dppf<0x143, 0xC>(x);
    return x;
}

__device__ __forceinline__ void transpose_item(const float* src, int src_ld, bf16* dst, int dst_ld, int k0, int ns0, int nd0, LAS float* scr, int lane) {
    f32x4 v[8];
#pragma unroll
    for (int it = 0; it < 8; ++it) { const int kk = (lane >> 3) + 8 * it; v[it] = *(const GAS f32x4*)(src + (size_t)(k0 + kk) * src_ld + ns0 + (lane & 7) * 4); }
#pragma unroll
    for (int it = 0; it < 8; ++it) { const int kk = (lane >> 3) + 8 * it; LAS float* s = scr + kk * 33 + (lane & 7) * 4; s[0] = v[it].x; s[1] = v[it].y; s[2] = v[it].z; s[3] = v[it].w; }
    LDS_WAIT(); asm volatile("" ::: "memory");
    const int c = lane & 7;
#pragma unroll
    for (int j = 0; j < 4; ++j) { const int n = (lane >> 3) + 8 * j; const LAS float* s = scr + (8 * c) * 33 + n;
        v4u o; o.x = pk2(s[0 * 33], s[1 * 33]); o.y = pk2(s[2 * 33], s[3 * 33]); o.z = pk2(s[4 * 33], s[5 * 33]); o.w = pk2(s[6 * 33], s[7 * 33]);
        *(GAS v4u*)(dst + (size_t)(nd0 + n) * dst_ld + k0 + 8 * c) = o; }
    LDS_WAIT(); asm volatile("" ::: "memory");
}
__device__ __forceinline__ void transpose_item8(const float* src, int src_ld, unsigned char* dst, int dst_ld, int k0, int ns0, int nd0, LAS float* scr, int lane, float scale) {
    f32x4 v[16];
#pragma unroll
    for (int it = 0; it < 16; ++it) { const int kk = (lane >> 3) + 8 * it; v[it] = __builtin_nontemporal_load((const GAS f32x4*)(src + (size_t)(k0 + kk) * src_ld + ns0 + (lane & 7) * 4)); }
#pragma unroll
    for (int it = 0; it < 16; ++it) { const int kk = (lane >> 3) + 8 * it; LAS float* s = scr + kk * 33 + ((((lane & 7) + (kk >> 4)) * 4) & 31);
        s[0] = v[it].x * scale; s[1] = v[it].y * scale; s[2] = v[it].z * scale; s[3] = v[it].w * scale; }
    LDS_WAIT(); asm volatile("" ::: "memory");
    const int c = lane & 7;
#pragma unroll
    for (int j = 0; j < 4; ++j) { const int n = (lane >> 3) + 8 * j; const LAS float* s = scr + (16 * c) * 33 + ((n + 4 * c) & 31);
        v4u o; o.x = pg8::pk4_fp8(s[0 * 33], s[1 * 33], s[2 * 33], s[3 * 33]); o.y = pg8::pk4_fp8(s[4 * 33], s[5 * 33], s[6 * 33], s[7 * 33]);
        o.z = pg8::pk4_fp8(s[8 * 33], s[9 * 33], s[10 * 33], s[11 * 33]); o.w = pg8::pk4_fp8(s[12 * 33], s[13 * 33], s[14 * 33], s[15 * 33]);
        *(GAS v4u*)(dst + (size_t)(nd0 + n) * dst_ld + k0 + 16 * c) = o; }
    LDS_WAIT(); asm volatile("" ::: "memory");
}
struct ProIn { const float *c, *gmix, *gffn, *ada_w, *ada_b, *pool_w, *pool_scale, *fox_w_in, *fox_w_o, *exp_w_in, *exp_w_out; };
__device__ __forceinline__ void p0_prologue(Frame& F0, const ProIn& P, unsigned char* ws) {
    Frame F = F0; { int t_ = F0.tid; asm volatile("" : "+v"(t_)); F.tid = t_; F.lane = t_ & 63; F.wave = __builtin_amdgcn_readfirstlane(t_ >> 6); }
    LAS float* sc = (LAS float*)(F.lds + RING_OFF);
    LAS float* red = (LAS float*)(F.lds + RING_OFF + 16384);
    for (int i = F.tid; i < BATCH * D; i += NWAVES * 64) { const float v = P.c[i]; sc[i] = v / (1.0f + __expf(-v)); }
    __syncthreads();
    float* MODV = (float*)(ws + WS_MODV);
    for (int it = F.bid; it < DEPTH * 48; it += F.G) {
        const int L = it / 48, n0 = (it % 48) * 128;
        const float* wp = P.ada_w + ((size_t)L * D + 128 * F.wave) * (6 * D) + n0 + 2 * F.lane;
        float a00 = 0.f, a01 = 0.f, a10 = 0.f, a11 = 0.f, a20 = 0.f, a21 = 0.f, a30 = 0.f, a31 = 0.f;
#pragma unroll 16
        for (int k = 0; k < 128; ++k) { const pg8::f32x2 wv = *(const GAS pg8::f32x2*)(wp + (size_t)k * (6 * D)); const int kk = 128 * F.wave + k;
            const float s0 = sc[kk], s1 = sc[D + kk], s2 = sc[2 * D + kk], s3 = sc[3 * D + kk];
            a00 += s0 * wv.x; a01 += s0 * wv.y; a10 += s1 * wv.x; a11 += s1 * wv.y; a20 += s2 * wv.x; a21 += s2 * wv.y; a30 += s3 * wv.x; a31 += s3 * wv.y; }
        { LAS pg8::f32x2* rp = (LAS pg8::f32x2*)(red + (F.wave * 4) * 128) + F.lane;
          rp[0] = (pg8::f32x2){a00, a01}; rp[64] = (pg8::f32x2){a10, a11}; rp[128] = (pg8::f32x2){a20, a21}; rp[192] = (pg8::f32x2){a30, a31}; }
        __syncthreads();
        { const int b = F.tid >> 7, ln = F.tid & 127, nn = n0 + ln; float m = P.ada_b[L * 6 * D + nn];
#pragma unroll
            for (int w = 0; w < 8; ++w) m += red[(w * 4 + b) * 128 + ln];
            const int j = nn >> 10, cc = nn & 1023;
            if (j == 1) m = P.gmix[L * D + cc] * (1.0f + m);
            else if (j == 2) { if (!(L & 1)) m *= P.pool_scale[(L >> 1) * D + cc]; }
            else if (j == 4) m = P.gffn[L * D + cc] * (1.0f + m);
            MODV[((size_t)(L * BATCH + b) * 6 + j) * D + cc] = m; }
        __syncthreads();
    }
    LAS float* scr = (LAS float*)(F.lds + RING_OFF + F.wave * 16896);
    const int gw = F.bid * NWAVES + F.wave, NGW = F.G * NWAVES;
    static_assert(8 * 16896 <= MISC_OFF, "prologue scratch vs LDS map");
    constexpr int I_W1 = DEPTH * NEXP * 512, I_W2 = DEPTH * NEXP * 256, I_QKV = 2 * 768, I_WO = 2 * 256, I_PL = 8 * 32;
    for (int it = gw; it < I_W1 + I_W2 + I_QKV + I_WO + I_PL; it += NGW) {
        int r = it;
        if (r < I_W1) { const int m = r >> 9, q = r & 511, kb = q >> 6, nb = q & 63, nd0 = 32 * nb, pn = nd0 >> 8, j = nd0 & 255;
            const int ns0 = (j < 128) ? (128 * pn + j) : (FF + 128 * pn + (j - 128));
            transpose_item8(P.exp_w_in + (size_t)m * D * 2 * FF, 2 * FF, (unsigned char*)(ws + WS_W1) + (size_t)m * 2 * FF * D, D, 128 * kb, ns0, nd0, scr, F.lane, pg8::FP8_SW); continue; }
        r -= I_W1;
        if (r < I_W2) { const int m = r >> 8, q = r & 255, kb = q >> 5, nb = q & 31;
            transpose_item8(P.exp_w_out + (size_t)m * FF * D, D, (unsigned char*)(ws + WS_W2) + (size_t)m * D * FF, FF, 128 * kb, 32 * nb, 32 * nb, scr, F.lane, pg8::FP8_SW); continue; }
        r -= I_W2;
        if (r < I_QKV) { const int m = r / 768, q = r % 768, kb = q / 96, nb = q % 96;
            transpose_item8(P.fox_w_in + (size_t)m * D * FOX_LD, FOX_LD, (unsigned char*)(ws + WS_WQKV) + (size_t)m * NQKV * D, D, 128 * kb, 32 * nb, 32 * nb, scr, F.lane, pg8::FP8_SW); continue; }
        r -= I_QKV;
        if (r < I_WO) { const int m = r >> 8, q = r & 255, kb = q >> 5, nb = q & 31;
            transpose_item8(P.fox_w_o + (size_t)m * D * D, D, (unsigned char*)(ws + WS_WO) + (size_t)m * D * D, D, 128 * kb, 32 * nb, 32 * nb, scr, F.lane, pg8::FP8_SW); continue; }
        r -= I_WO;
        { const int m = r >> 5, q = r & 31, kb = q >> 3, nb = q & 7;
            transpose_item(P.pool_w + (size_t)m * 65536, 256, (bf16*)(ws + WS_WPOOL) + (size_t)m * 65536, 256, 64 * kb, 32 * nb, 32 * nb, scr, F.lane); }
    }
}

__device__ __forceinline__ f32x4 fp8x4_f32(unsigned w) { typedef float f2 __attribute__((ext_vector_type(2))); const f2 lo = __builtin_amdgcn_cvt_pk_f32_fp8((int)w, false), hi = __builtin_amdgcn_cvt_pk_f32_fp8((int)w, true); return (f32x4){lo.x, lo.y, hi.x, hi.y}; }
__device__ __forceinline__ f32x4 ys_sum4(unsigned a, unsigned b, unsigned c, unsigned d) { return (fp8x4_f32(a) + fp8x4_f32(b)) + (fp8x4_f32(c) + fp8x4_f32(d)); }
template <bool BF> struct XRaw { typedef f32x4 T; };
template <> struct XRaw<true> { typedef v2u T; };
template <bool BF> __device__ __forceinline__ typename XRaw<BF>::T ldxraw(const void* base, size_t eoff) {
    if constexpr (BF) return *(const GAS v2u*)((const bf16*)base + eoff); else return *(const GAS f32x4*)((const float*)base + eoff);
}
__device__ __forceinline__ f32x4 xraw_f32(v2u w) { return (f32x4){bflo(w.x), bfhi(w.x), bflo(w.y), bfhi(w.y)}; }
__device__ __forceinline__ f32x4 xraw_f32(f32x4 w) { return w; }
template <int MODE, bool SRCBF>
__device__ __forceinline__ void rows_phase(Frame& F0, bool combine, const void* xsrc, void* xdst, const unsigned char* ys, const float* g2v, float* r1out, const float* fg) {
    Frame F = F0; { int t_ = F0.tid; asm volatile("" : "+v"(t_)); F.tid = t_; F.lane = t_ & 63; F.wave = __builtin_amdgcn_readfirstlane(t_ >> 6); }
    typedef typename XRaw<SRCBF>::T XT;
    const int gw = F.bid * NWAVES + F.wave, NGW = F.G * NWAVES, per = (T + NGW - 1) / NGW, r0 = gw * per, r1 = (r0 + per < T) ? r0 + per : T;
    if (r0 >= r1) return;
    XT xn[4]; unsigned yn[4][4];
#define RP_LOAD(rw) do { _Pragma("unroll") for (int j_ = 0; j_ < 4; ++j_) xn[j_] = ldxraw<SRCBF>(xsrc, (size_t)(rw) * D + 4 * F.lane + 256 * j_); \
        if (combine) { _Pragma("unroll") for (int k_ = 0; k_ < 4; ++k_) { _Pragma("unroll") for (int j_ = 0; j_ < 4; ++j_) yn[k_][j_] = *((const GAS unsigned*)(ys + ((size_t)(rw) * 4 + k_) * D) + F.lane + 64 * j_); } } } while (0)
    RP_LOAD(r0);
    f32x4 fgv[4], g2r[4]; int bcur = -1;
    if (MODE == 1) {
#pragma unroll
        for (int j = 0; j < 4; ++j) fgv[j] = *((const GAS f32x4*)fg + F.lane + 64 * j); }
#pragma unroll 1
    for (int row = r0; row < r1; ++row) {
        const int b = row >> 13;
        XT xc[4]; unsigned yc[4][4];
#pragma unroll
        for (int j = 0; j < 4; ++j) { xc[j] = xn[j];
#pragma unroll
            for (int k = 0; k < 4; ++k) yc[k][j] = yn[k][j]; }
        if (combine && b != bcur) {
#pragma unroll
            for (int j = 0; j < 4; ++j) g2r[j] = *((const GAS f32x4*)(g2v + (size_t)b * 6 * D) + F.lane + 64 * j) * (1.0f / pg8::YS_SCALE);
            bcur = b; }
        if (row + 1 < r1) RP_LOAD(row + 1);
        f32x4 v[4];
#pragma unroll
        for (int j = 0; j < 4; ++j) v[j] = xraw_f32(xc[j]);
        if (combine) {
#pragma unroll
            for (int j = 0; j < 4; ++j) v[j] = v[j] + g2r[j] * ys_sum4(yc[0][j], yc[1][j], yc[2][j], yc[3][j]);
        }
        float ss = 0.f;
#pragma unroll
        for (int j = 0; j < 4; ++j) ss += (v[j].x * v[j].x + v[j].y * v[j].y) + (v[j].z * v[j].z + v[j].w * v[j].w);
        const float r = 1.0f / sqrtf(wave_sum(ss) * (1.0f / D) + EPS);
        if (MODE == 0) {
            if (combine) {
#pragma unroll
                for (int j = 0; j < 4; ++j) stx4_bf((bf16*)xdst, (size_t)row * D + 4 * F.lane + 256 * j, v[j]); }
            if (F.lane == 0) r1out[row] = r;
        } else {
            GAS f32x4* xo = (GAS f32x4*)((float*)xdst + (size_t)row * D) + F.lane;
#pragma unroll
            for (int j = 0; j < 4; ++j) xo[64 * j] = v[j] * r * fgv[j];
        }
    }
#undef RP_LOAD
}

template <bool SRCBF>
__device__ __forceinline__ void pool_d_phase(Frame& F0, const void* xsrc, const float* r1, const float* G1v, bf16* dout) {
    Frame F = F0; { int t_ = F0.tid; asm volatile("" : "+v"(t_)); F.tid = t_; F.lane = t_ & 63; F.wave = __builtin_amdgcn_readfirstlane(t_ >> 6); }
    typedef typename XRaw<SRCBF>::T XT;
    const int half = F.tid >> 8, cq = F.tid & 255, c0 = 4 * cq, w = __builtin_amdgcn_readfirstlane(2 << (cq >> 6));
    LAS f32x4* ring = (LAS f32x4*)(F.lds + RING_OFF) + F.tid;
    static_assert(16 * NWAVES * 64 * 16 <= RING_BYTES, "pool ring");
    for (int tile = F.bid; tile < T / 64; tile += F.G) {
        const int t0 = tile * 64 + 32 * half, b = t0 >> 13, tl0 = t0 & (SEQ - 1);
        const f32x4 Gc = *(const GAS f32x4*)(G1v + (size_t)b * 6 * D + c0);
        const size_t xb = (size_t)t0 * D + c0;
        const int kfirst = (-(w - 1) > -tl0) ? -(w - 1) : -tl0;
        f32x4 s = pg8::zero4();
        XT XA[8], XB[8]; float RA[8], RB[8];
#define PD_LOAD(XQ, RQ, kc) do { if ((kc) + 7 >= kfirst) { _Pragma("unroll") for (int j_ = 0; j_ < 8; ++j_) { const int k_ = (kc) + j_; if (k_ >= kfirst) { \
            XQ[j_] = ldxraw<SRCBF>(xsrc, (size_t)((long)xb + (long)k_ * D)); RQ[j_] = r1[t0 + k_]; } } } } while (0)
#define PD_PROC(XQ, RQ, kc) do { if ((kc) + 7 >= kfirst) { _Pragma("unroll") for (int j_ = 0; j_ < 8; ++j_) { const int k_ = (kc) + j_; if (k_ >= kfirst) { \
            const f32x4 v = xraw_f32(XQ[j_]) * RQ[j_]; s = s + v; ring[(k_ & 15) * (NWAVES * 64)] = v; \
            if (k_ >= 0) { const int tl = tl0 + k_; const float inv = 1.0f / (float)((tl + 1 < w) ? (tl + 1) : w); \
                const f32x4 d = Gc * (s * inv - v); v2u o; o.x = pk2(d.x, d.y); o.y = pk2(d.z, d.w); \
                *(GAS v2u*)(dout + (size_t)(t0 + k_) * D + c0) = o; \
                if (tl - (w - 1) >= 0) s = s - ring[((k_ - (w - 1)) & 15) * (NWAVES * 64)]; } } } } } while (0)
        PD_LOAD(XA, RA, -16); PD_LOAD(XB, RB, -8);
        PD_PROC(XA, RA, -16); PD_LOAD(XA, RA, 0);
        PD_PROC(XB, RB, -8);  PD_LOAD(XB, RB, 8);
        PD_PROC(XA, RA, 0);   PD_LOAD(XA, RA, 16);
        PD_PROC(XB, RB, 8);   PD_LOAD(XB, RB, 24);
        PD_PROC(XA, RA, 16);
        PD_PROC(XB, RB, 24);
#undef PD_LOAD
#undef PD_PROC
    }
}

constexpr int NP_TROW = 1032;
constexpr int NP_TILE = 0, NP_TLO = 16 * NP_TROW * 2, NP_PART = 66048, NP_LOGI = NP_PART + 16384, NP_PE = NP_LOGI + 2048, NP_PPOS = NP_PE + 4096, NP_PG = NP_PPOS + 4096, NP_PPAIR = NP_PG + 4096, NP_LCNT = NP_PPAIR + 4096, NP_BASE = NP_LCNT + 128, NP_TOPV = NP_BASE + 128, NP_MOD = NP_TOPV + 256, NP_END = NP_MOD + 3 * 4096;
static_assert(NP_END <= RING_BYTES && NP_MOD % 16 == 0, "norm phase LDS");
#define LDS_BARRIER() do { asm volatile("s_waitcnt lgkmcnt(0)" ::: "memory"); __builtin_amdgcn_s_barrier(); asm volatile("" ::: "memory"); } while (0)
template <bool FOX>
__device__ __forceinline__ void norm_proj_phase(Frame& F0, const bf16* xsrc, bf16* xdst, const unsigned char* ys, const float* g2v, const float* Gv, const float* Sv,
                                                const float* W, int w_ld, const float* bias, bf16* hout, float* LF, unsigned* gcnt, int* slot_pair, float* slot_gate, bool dry = false) {
    constexpr int NEC = FOX ? 16 : 32, NEH = NEC / 16, NYK = FOX ? 4 : 1;
    Frame F = F0; { int t_ = F0.tid; asm volatile("" : "+v"(t_)); F.tid = t_; F.lane = t_ & 63; F.wave = __builtin_amdgcn_readfirstlane(t_ >> 6); }
    LAS unsigned short* THI = (LAS unsigned short*)(F.lds + NP_TILE); LAS unsigned short* TLO = (LAS unsigned short*)(F.lds + NP_TLO); LAS float* PART = (LAS float*)(F.lds + NP_PART); LAS float* LOGI = (LAS float*)(F.lds + NP_LOGI);
    LAS int* P_E = (LAS int*)(F.lds + NP_PE); LAS int* P_POS = (LAS int*)(F.lds + NP_PPOS); LAS float* P_G = (LAS float*)(F.lds + NP_PG); LAS int* P_PAIR = (LAS int*)(F.lds + NP_PPAIR);
    LAS int* LCNT = (LAS int*)(F.lds + NP_LCNT); LAS int* BASE = (LAS int*)(F.lds + NP_BASE); LAS float* TOPV = (LAS float*)(F.lds + NP_TOPV); LAS float* MOD = (LAS float*)(F.lds + NP_MOD);
    const int lane = F.lane, w = F.wave, r = lane & 15, q = lane >> 4;
    const int NT = T / 16, per = (NT + F.G - 1) / F.G, tl0 = F.bid * per, tl1 = (tl0 + per < NT) ? tl0 + per : NT;
    v2u xn[2][4]; unsigned yn[2][NYK][4];
#define NP_LOADX(tlx) do { _Pragma("unroll") for (int rr_ = 0; rr_ < 2; ++rr_) { const int tk_ = (tlx) * 16 + 2 * w + rr_; const GAS v2u* xr_ = (const GAS v2u*)(xsrc + (size_t)tk_ * D) + lane; \
        _Pragma("unroll") for (int j_ = 0; j_ < 4; ++j_) xn[rr_][j_] = xr_[64 * j_]; \
        if (FOX) { _Pragma("unroll") for (int k_ = 0; k_ < NYK; ++k_) { _Pragma("unroll") for (int j_ = 0; j_ < 4; ++j_) yn[rr_][k_][j_] = *((const GAS unsigned*)(ys + ((size_t)tk_ * 4 + k_) * D) + lane + 64 * j_); } } } } while (0)
    if (tl0 < tl1) NP_LOADX(tl0);
    const float bias_e = (F.tid < 16 * NEC) ? bias[F.tid % NEC] : 0.f;
    typedef short bf16x8v __attribute__((ext_vector_type(8)));
    v4u whi[4][NEH], wlo[4][NEH];
#pragma unroll
    for (int s = 0; s < 4; ++s)
#pragma unroll
        for (int eh = 0; eh < NEH; ++eh) { float wv[8];
#pragma unroll
            for (int j = 0; j < 8; ++j) wv[j] = W[(size_t)(128 * w + 32 * s + 8 * q + j) * w_ld + 16 * eh + r];
#pragma unroll
            for (int p = 0; p < 4; ++p) { const unsigned hb = pk2(wv[2 * p], wv[2 * p + 1]); whi[s][eh][p] = hb; wlo[s][eh][p] = pk2(wv[2 * p] - bflo(hb), wv[2 * p + 1] - bfhi(hb)); } }
    if (!FOX) { if (F.tid < 32) LCNT[F.tid] = 0; }
    int bcur = -1;
    int nloc = 0;
    for (int tl = tl0; tl < tl1; ++tl, ++nloc) {
        const int b = tl >> 9;
        if (b != bcur) {
            for (int i = F.tid; i < 768; i += NWAVES * 64) { const int vec = i >> 8, c4 = i & 255;
                if (FOX || vec > 0) { const float* src = (vec == 0) ? g2v : (vec == 1) ? Gv : Sv; f32x4 val = *((const GAS f32x4*)(src + (size_t)b * 6 * D) + c4);
                    if (vec == 0) val = val * (1.0f / pg8::YS_SCALE);
                    *(LAS f32x4*)(MOD + vec * 1024 + 4 * c4) = val; } }
            bcur = b;
            LDS_BARRIER();
        }
        v2u xc[2][4]; unsigned yc[2][NYK][4];
#pragma unroll
        for (int rr = 0; rr < 2; ++rr) {
#pragma unroll
            for (int j = 0; j < 4; ++j) xc[rr][j] = xn[rr][j];
            if (FOX) {
#pragma unroll
                for (int k = 0; k < NYK; ++k)
#pragma unroll
                    for (int j = 0; j < 4; ++j) yc[rr][k][j] = yn[rr][k][j]; } }
        if (tl + 1 < tl1) NP_LOADX(tl + 1);
#pragma unroll
        for (int rr = 0; rr < 2; ++rr) {
            const int row = 2 * w + rr, tok = tl * 16 + row;
            f32x4 v[4];
#pragma unroll
            for (int j = 0; j < 4; ++j) v[j] = (f32x4){bflo(xc[rr][j].x), bfhi(xc[rr][j].x), bflo(xc[rr][j].y), bfhi(xc[rr][j].y)};
            if (FOX) {
#pragma unroll
                for (int j = 0; j < 4; ++j) { const f32x4 g = *(const LAS f32x4*)(MOD + 4 * lane + 256 * j);
                    v[j] = v[j] + g * ys_sum4(yc[rr][0][j], yc[rr][NYK > 1 ? 1 : 0][j], yc[rr][NYK > 2 ? 2 : 0][j], yc[rr][NYK > 3 ? 3 : 0][j]); }
#pragma unroll
                for (int j = 0; j < 4; ++j) stx4_bf(xdst, (size_t)tok * D + 4 * lane + 256 * j, v[j]);
            }
            float ss = 0.f;
#pragma unroll
            for (int j = 0; j < 4; ++j) ss += (v[j].x * v[j].x + v[j].y * v[j].y) + (v[j].z * v[j].z + v[j].w * v[j].w);
            const float rinv = 1.0f / sqrtf(wave_sum(ss) * (1.0f / D) + EPS);
#pragma unroll
            for (int j = 0; j < 4; ++j) {
                const f32x4 g = *(const LAS f32x4*)(MOD + 1024 + 4 * lane + 256 * j), sh = *(const LAS f32x4*)(MOD + 2048 + 4 * lane + 256 * j);
                const f32x4 h = v[j] * rinv * g + sh;
                *((GAS unsigned*)((unsigned char*)hout + (size_t)tok * D) + lane + 64 * j) = pg8::pk4_fp8(h.x * pg8::FP8_SA, h.y * pg8::FP8_SA, h.z * pg8::FP8_SA, h.w * pg8::FP8_SA);
                { v2u hh; hh.x = pk2(h.x, h.y); hh.y = pk2(h.z, h.w); v2u hl; hl.x = pk2(h.x - bflo(hh.x), h.y - bfhi(hh.x)); hl.y = pk2(h.z - bflo(hh.y), h.w - bfhi(hh.y));
                  *(LAS v2u*)(THI + row * NP_TROW + 256 * j + 4 * lane) = hh; *(LAS v2u*)(TLO + row * NP_TROW + 256 * j + 4 * lane) = hl; }
            }
        }
        LDS_BARRIER();
        {
            f32x4 acc[NEH];
#pragma unroll
            for (int eh = 0; eh < NEH; ++eh) acc[eh] = pg8::zero4();
#pragma unroll
            for (int s = 0; s < 4; ++s) { const v4u ah = *(const LAS v4u*)(THI + r * NP_TROW + 128 * w + 32 * s + 8 * q), al = *(const LAS v4u*)(TLO + r * NP_TROW + 128 * w + 32 * s + 8 * q);
#pragma unroll
                for (int eh = 0; eh < NEH; ++eh) {
                    acc[eh] = __builtin_amdgcn_mfma_f32_16x16x32_bf16(__builtin_bit_cast(bf16x8v, ah), __builtin_bit_cast(bf16x8v, whi[s][eh]), acc[eh], 0, 0, 0);
                    acc[eh] = __builtin_amdgcn_mfma_f32_16x16x32_bf16(__builtin_bit_cast(bf16x8v, al), __builtin_bit_cast(bf16x8v, whi[s][eh]), acc[eh], 0, 0, 0);
                    acc[eh] = __builtin_amdgcn_mfma_f32_16x16x32_bf16(__builtin_bit_cast(bf16x8v, ah), __builtin_bit_cast(bf16x8v, wlo[s][eh]), acc[eh], 0, 0, 0); } }
#pragma unroll
            for (int eh = 0; eh < NEH; ++eh)
#pragma unroll
                for (int i = 0; i < 4; ++i) PART[(w * 16 + 4 * q + i) * 32 + 16 * eh + r] = acc[eh][i];
        }
        LDS_BARRIER();
        float logit_own = bias_e;
        if (F.tid < 16 * NEC) { const int token = F.tid / NEC, e = F.tid % NEC;
#pragma unroll
            for (int ww = 0; ww < 8; ++ww) logit_own += PART[(ww * 16 + token) * 32 + e];
            if (!FOX) LOGI[token * 32 + e] = logit_own; }
        LDS_WAIT(); asm volatile("" ::: "memory");
        if (FOX) {
            if (F.tid < 256) { const int token = F.tid >> 4, hh = F.tid & 15; const float z = logit_own;
                const float lf = fminf(z, 0.f) - 0.69314718056f * __builtin_amdgcn_logf(1.0f + __builtin_amdgcn_exp2f(-1.4426950408889634f * fabsf(z)));
                const int tg = tl * 16 + token; LF[((size_t)(tg >> 13) * NH + hh) * SEQ + (tg & (SEQ - 1))] = lf; }
        } else if (nloc < 16) {
            const int token = F.tid >> 5, e = F.tid & 31; const LAS float* lg = LOGI + token * 32; const float v = lg[e]; int rank = 0;
#pragma unroll
            for (int e2 = 0; e2 < 32; ++e2) { const float o = lg[e2]; rank += (o > v || (o == v && e2 < e)) ? 1 : 0; }
            if (rank < 4) TOPV[token * 4 + rank] = v;
            LDS_WAIT(); asm volatile("" ::: "memory");
            if (rank < 4) { const float t0 = TOPV[token * 4], e0 = __expf(TOPV[token * 4 + 1] - t0), e1 = __expf(TOPV[token * 4 + 2] - t0), e2x = __expf(TOPV[token * 4 + 3] - t0);
                const float gate = __expf(v - t0) / (1.0f + e0 + e1 + e2x);
                const int pl = nloc * 64 + token * 4 + rank;
                const int lp = __hip_atomic_fetch_add((int*)(LCNT + e), 1, __ATOMIC_RELAXED, __HIP_MEMORY_SCOPE_WORKGROUP);
                P_E[pl] = e; P_POS[pl] = lp; P_G[pl] = gate; P_PAIR[pl] = (tl * 16 + token) * 4 + rank; }
        }
    }
#undef NP_LOADX
    if (!FOX) {
        __syncthreads();
        if (F.tid < 32) BASE[F.tid] = dry ? 0 : (int)__hip_atomic_fetch_add(gcnt + F.tid, (unsigned)LCNT[F.tid], RLX_AGENT);
        __syncthreads();
        const int np = dry ? 0 : (nloc < 16 ? nloc : 16) * 64;
        for (int pl = F.tid; pl < np; pl += NWAVES * 64) { const int e = P_E[pl]; const size_t slot = (size_t)e * T + BASE[e] + P_POS[pl];
            slot_pair[slot] = P_PAIR[pl]; slot_gate[slot] = P_G[pl]; }
    }
    __syncthreads();
}

__device__ __forceinline__ void fox_scan(Frame& F0, const float* LF, float* FB) {
    Frame F = F0; { int t_ = F0.tid; asm volatile("" : "+v"(t_)); F.tid = t_; F.lane = t_ & 63; F.wave = __builtin_amdgcn_readfirstlane(t_ >> 6); }
    LAS float* wt = (LAS float*)(F.lds + RING_OFF);
    constexpr int QL = SEQ / 4;
    static_assert(QL == NWAVES * 64 * 4, "one f32x4 per thread and quarter");
    for (int item = F.bid; item < BATCH * NH * 4; item += F.G) {
        const int seq = item >> 2, qtr = item & 3;
        const GAS f32x4* base = (const GAS f32x4*)(LF + (size_t)seq * SEQ) + F.tid;
        const f32x4 v = base[qtr * (QL / 4)];
        f32x4 pv[3];
#pragma unroll
        for (int pq = 0; pq < 3; ++pq) pv[pq] = (pq < qtr) ? base[pq * (QL / 4)] : pg8::zero4();
        float psum = 0.f;
#pragma unroll
        for (int pq = 0; pq < 3; ++pq) psum += (pv[pq].x + pv[pq].y) + (pv[pq].z + pv[pq].w);
        const float c0 = v.x, c1 = c0 + v.y, c2 = c1 + v.z, run = c2 + v.w;
        const float incl = wave_incl_scan(run), ptot = wave_sum(psum);
        if (F.lane == 63) { wt[F.wave] = incl; wt[8 + F.wave] = ptot; }
        __syncthreads();
        float off = incl - run;
#pragma unroll
        for (int ww = 0; ww < 8; ++ww) { off += wt[8 + ww]; if (ww < F.wave) off += wt[ww]; }
        GAS f32x4* dst = (GAS f32x4*)(FB + (size_t)seq * SEQ + qtr * QL) + F.tid;
        *dst = (f32x4){(off + c0) * -1.4426950408889634f, (off + c1) * -1.4426950408889634f, (off + c2) * -1.4426950408889634f, (off + run) * -1.4426950408889634f};
        __syncthreads();
    }
}

constexpr int UL_OFF = SCHED_OFF + 320, UL_MAX = 24;
__device__ __forceinline__ void moe_setup(Frame& F0, const unsigned* gcnt, int nN, bool reuse = false) {
    Frame F = F0; { int t_ = F0.tid; asm volatile("" : "+v"(t_)); F.tid = t_; F.lane = t_ & 63; F.wave = __builtin_amdgcn_readfirstlane(t_ >> 6); }
    LAS int* CNT = (LAS int*)(F.lds + SCHED_OFF); LAS int* TPRE = CNT + 32; LAS int* UL = (LAS int*)(F.lds + UL_OFF);
    __syncthreads();
    if (!reuse) {
        if (F.tid < 32) { const unsigned c = __hip_atomic_load(gcnt + F.tid, RLX_AGENT); CNT[F.tid] = (int)(c < (unsigned)T ? c : (unsigned)T); }
        __syncthreads();
        if (F.tid < 64) {
            const int e = F.tid; const float tl = (e < 32) ? (float)((CNT[e & 31] + 255) >> 8) : 0.f; const float inc = wave_incl_scan(tl);
            if (e < 32) TPRE[e] = (int)(inc - tl);
            if (e == 31) { const int a = (int)inc; TPRE[32] = a < MAXMT ? a : MAXMT; } }
        __syncthreads();
    }
    if (F.tid < UL_MAX) { const int MT = TPRE[32]; int pm = -1, pn = 0, e = 0;
        if (F.tid < UL_MAX - 1 && pg8::tile_order(F.tid, F.G, F.bid, MT, nN, pm, pn)) { for (int st = 16; st >= 1; st >>= 1) if (e + st < 32 && TPRE[e + st] <= pm) e += st;        } else pm = -1;
        LAS int* p = UL + 5 * F.tid; p[0] = pm; p[1] = pn; p[2] = e; p[3] = CNT[e]; p[4] = pm - TPRE[e]; }
    __syncthreads();
}
__device__ __forceinline__ void qk_stats_phase(Frame& F0, const bf16* Q, const bf16* K, unsigned* QN2, unsigned* KN2) {
    Frame F = F0; { int t_ = F0.tid; asm volatile("" : "+v"(t_)); F.tid = t_; F.lane = t_ & 63; F.wave = __builtin_amdgcn_readfirstlane(t_ >> 6); }
    const int gw = F.bid * NWAVES + F.wave, NGW = F.G * NWAVES;
    for (int it = gw; it < T / 16; it += NGW) {
        const int t0 = it * 16; float qm = 0.f, km = 0.f;
#pragma unroll 4
        for (int i = 0; i < 16; ++i) {
            const GAS v4u* qp = (const GAS v4u*)(Q + (size_t)(t0 + i) * D + 16 * F.lane); const GAS v4u* kp = (const GAS v4u*)(K + (size_t)(t0 + i) * D + 16 * F.lane);
            const v4u qa = qp[0], qb = qp[1], ka = kp[0], kb = kp[1];
            float qs = 0.f, ks = 0.f;
#pragma unroll
            for (int e = 0; e < 4; ++e) { qs += bflo(qa[e]) * bflo(qa[e]) + bfhi(qa[e]) * bfhi(qa[e]) + bflo(qb[e]) * bflo(qb[e]) + bfhi(qb[e]) * bfhi(qb[e]);
                                          ks += bflo(ka[e]) * bflo(ka[e]) + bfhi(ka[e]) * bfhi(ka[e]) + bflo(kb[e]) * bflo(kb[e]) + bfhi(kb[e]) * bfhi(kb[e]); }
            qs += dppf<0xB1>(qs); qs += dppf<0x4E>(qs); ks += dppf<0xB1>(ks); ks += dppf<0x4E>(ks);
            qm = fmaxf(qm, qs); km = fmaxf(km, ks);
        }
        if ((F.lane & 3) == 0) { const int b = t0 >> 13, h = F.lane >> 2, qb = (t0 & (SEQ - 1)) >> 8;
            __hip_atomic_fetch_max(QN2 + (b * NH + h) * 32 + qb, __float_as_uint(qm), RLX_AGENT); __hip_atomic_fetch_max(KN2 + b * NH + h, __float_as_uint(km), RLX_AGENT); }
    }
}
constexpr int PH_FINAL = 1 + 8 * DEPTH, NPH = PH_FINAL + 1;
struct Args { const float* in[18]; float* out; unsigned char* ws; int ph_lo, ph_hi; };
#define KARG() ({ const __attribute__((address_space(4))) Args* p_ = (const __attribute__((address_space(4))) Args*)__builtin_amdgcn_kernarg_segment_ptr(); asm volatile("" : "+s"(p_)); p_; })
#define MKFRAME(F, ws) Frame F; F.lds = (LAS unsigned char*)lds; F.MISC = (volatile LAS unsigned*)(F.lds + MISC_OFF); F.tid = threadIdx.x; F.lane = F.tid & 63; F.wave = __builtin_amdgcn_readfirstlane(F.tid >> 6); { int g_ = gridDim.x, b_ = blockIdx.x; asm volatile("" : "+s"(g_), "+s"(b_)); F.G = g_; F.bid = b_; } F.ctl = (gu32*)((ws) + WS_CTL)
__global__ void __launch_bounds__(NWAVES * 64, 2) enc_fwd(Args args) {
    extern __shared__ __attribute__((aligned(16))) unsigned char lds[];
    {
        for (int u = threadIdx.x; u < (LDS_BYTES - IDX_OFF) / 4; u += NWAVES * 64) ((LAS unsigned*)((LAS unsigned char*)lds + IDX_OFF))[u] = 0u;
        __syncthreads();
        if (MK_N_LAUNCHES == 1) { const auto* ap = KARG(); (void)xcd_barrier_post((unsigned*)((gu32*)(ap->ws + WS_CTL) + CW_BAR), (volatile LAS unsigned*)((LAS unsigned char*)lds + MISC_OFF) + 8); }
    }
#define SEAM() do { if (MK_N_LAUNCHES == 1) { const auto* ap_ = KARG(); XcdBarrier bar_; bar_.bar = (unsigned*)((gu32*)(ap_->ws + WS_CTL) + CW_BAR); bar_.x = xb_xcc_id(); bar_.st = (volatile LAS unsigned*)((LAS unsigned char*)lds + MISC_OFF) + 8; xcd_barrier(bar_); } } while (0)
    const int lo = args.ph_lo, hi = args.ph_hi;
#ifndef DBG_MASK
#define DBG_MASK 0xFFFF
#endif
#define EN(b) ((DBG_MASK >> (b)) & 1)
#ifndef DBG_DUP
#define DBG_DUP 0
#endif
#define REPS(b) for (int rep_ = 0; rep_ < (((DBG_DUP >> (b)) & 1) ? 2 : 1); ++rep_)
#define IN(k) (lo <= (k) && (k) < hi)
#define P_MODV(ws) ((float*)((ws) + WS_MODV))
#define P_HB(ws) ((bf16*)((ws) + WS_HB))
#define P_YS(ws) ((unsigned char*)((ws) + WS_YS))

    if (EN(0) && IN(0)) {
        REPS(0) { const auto* ap = KARG(); unsigned char* ws = ap->ws; MKFRAME(F, ws);
            ProIn P{ap->in[1], ap->in[2], ap->in[3], ap->in[4], ap->in[5], ap->in[6], ap->in[7], ap->in[8], ap->in[10], ap->in[13], ap->in[15]};
            p0_prologue(F, P, ws);
            if (MK_NBRANCH > 0) rows_phase<0, false>(F, false, ap->in[0], nullptr, P_YS(ws), P_MODV(ws), (float*)(ws + WS_R1), nullptr);
            SEAM(); }
    }
#pragma unroll 1
    for (int L = 0; L < DEPTH; ++L) {
        const int ph = 1 + 8 * L, jx = L >> 1;
        const bool odd = (L & 1) != 0, do_mix = (2 * L < MK_NBRANCH), do_moe = (2 * L + 1 < MK_NBRANCH);
#define P_XB(ws) ((bf16*)((ws) + WS_XB))
#define MV(ws) (P_MODV(ws) + (size_t)L * BATCH * 6 * D)
#define MVP(ws) (P_MODV(ws) + (size_t)(L > 0 ? L - 1 : 0) * BATCH * 6 * D)
        if (do_mix) {
            if (!odd) {
                if (EN(1) && IN(ph + 0) && L > 0) REPS(1) { const auto* ap = KARG(); unsigned char* ws = ap->ws; MKFRAME(F, ws); const bool dry = (rep_ == 0) && ((DBG_DUP >> 1) & 1);
                    rows_phase<0, true>(F, true, P_XB(ws), dry ? (void*)(ws + WS_ACT) : (void*)P_XB(ws), P_YS(ws), MVP(ws) + 5 * D, (float*)(ws + WS_R1), nullptr); SEAM(); }
                if (EN(2) && IN(ph + 1)) REPS(2) { const auto* ap = KARG(); unsigned char* ws = ap->ws; MKFRAME(F, ws);
                    if (L == 0) pool_d_phase<false>(F, ap->in[0], (const float*)(ws + WS_R1), MV(ws) + 1 * D, P_HB(ws)); else pool_d_phase<true>(F, P_XB(ws), (const float*)(ws + WS_R1), MV(ws) + 1 * D, P_HB(ws)); SEAM(); }
            } else {
                if (EN(3) && IN(ph + 0)) REPS(3) { const auto* ap = KARG(); unsigned char* ws = ap->ws; MKFRAME(F, ws); const bool dry = (rep_ == 0) && ((DBG_DUP >> 3) & 1);
                    norm_proj_phase<true>(F, P_XB(ws), dry ? (bf16*)(ws + WS_ACT) : P_XB(ws), P_YS(ws), MVP(ws) + 5 * D, MV(ws) + 1 * D, MV(ws) + 0 * D, ap->in[8] + (size_t)jx * D * FOX_LD + NQKV, FOX_LD, ap->in[9] + jx * NH, dry ? (bf16*)(ws + WS_K) : P_HB(ws), (float*)(ws + (dry ? WS_FB : WS_LF)), nullptr, nullptr, nullptr); SEAM(); }
                if (EN(4) && IN(ph + 1)) {
                    REPS(4) { const auto* ap = KARG(); unsigned char* ws = ap->ws; MKFRAME(F, ws);
                    fox_scan(F, (const float*)(ws + WS_LF), (float*)(ws + WS_FB));
                    pg8::SchedDenseT<true> S{(const char*)P_HB(ws), (const char*)(ws + WS_WQKV) + (size_t)jx * NQKV * D, (size_t)256 * D, (size_t)256 * D, 0, T / 256, NQKV / 256, F.G, F.bid};
                    pg8::EpiQKV E{(bf16*)(ws + WS_Q), (size_t)(WS_K - WS_Q) / 2, attn_body::C2, 1.0f / (pg8::FP8_SA * pg8::FP8_SW), (unsigned*)(F.ctl + CW_QN2) + jx * 4096, (unsigned*)(F.ctl + CW_KN2) + jx * 128};
                    pg8::gemm_phase<pg8::EpiQKV, pg8::SchedDenseT<true>, true, true>(F.lds + RING_OFF, F.lds + IDX_OFF, D / 128, D, D, S, E); SEAM(); }
                }
                if (EN(5) && IN(ph + 2)) {
                    static_assert(attn_body::ATTN_LDS_BYTES <= RING_BYTES && attn_body::ATTN_PITCH == D, "attention body geometry vs frame");
                    REPS(5) { const auto* ap = KARG(); unsigned char* ws = ap->ws; gu32* ctl = (gu32*)(ws + WS_CTL);
                    const attn_body::AttnTensors AT{(const attn_body::bf16*)(ws + WS_Q), (const attn_body::bf16*)(ws + WS_K), (const attn_body::bf16*)(ws + WS_V), (attn_body::bf16*)(ws + WS_HB), (const float*)(ws + WS_FB), (const unsigned*)(ctl + CW_QN2) + jx * 4096, (const unsigned*)(ctl + CW_KN2) + jx * 128};
                    int g_ = gridDim.x, b_ = blockIdx.x; asm volatile("" : "+s"(g_), "+s"(b_)); const attn_body::StaticOrder S(g_, b_);
                    attn_body::attn_phase<attn_body::StaticOrder>((char*)lds + RING_OFF, AT, S, (volatile LAS int*)((LAS unsigned char*)lds + SCHED_OFF)); SEAM(); }
                }
            }
            if (EN(6) && IN(ph + (odd ? 3 : 2))) REPS(6) { const auto* ap = KARG(); unsigned char* ws = ap->ws; MKFRAME(F, ws); const bool dry = (rep_ == 0) && ((DBG_DUP >> 6) & 1);
                if (!odd) {
                    pg8::SchedDense S{(const char*)P_HB(ws), (const char*)((bf16*)(ws + WS_WPOOL) + (size_t)jx * 4 * 65536), (size_t)256 * D * 2, (size_t)256 * 256 * 2, 512, T / 256, 4, F.G, F.bid};
                    pg8::EpiResid E{(L == 0) ? (const void*)ap->in[0] : (const void*)P_XB(ws), L != 0, dry ? (bf16*)(ws + WS_ACT) : P_XB(ws), MV(ws) + 2 * D, 6 * D, 1.0f};
                    pg8::gemm_phase<pg8::EpiResid, pg8::SchedDense, true, false>(F.lds + RING_OFF, F.lds + IDX_OFF, 256 / 64, D * 2, 256 * 2, S, E);
                } else {
                    pg8::SchedDenseT<true> S{(const char*)P_HB(ws), (const char*)(ws + WS_WO) + (size_t)jx * D * D, (size_t)256 * D, (size_t)256 * D, 0, T / 256, 4, F.G, F.bid};
                    pg8::EpiResid E{(const void*)P_XB(ws), true, dry ? (bf16*)(ws + WS_ACT) : P_XB(ws), MV(ws) + 2 * D, 6 * D, 1.0f / (attn_body::O_SCALE * pg8::FP8_SW)};
                    pg8::gemm_phase<pg8::EpiResid, pg8::SchedDenseT<true>, true, true>(F.lds + RING_OFF, F.lds + IDX_OFF, D / 128, D, D, S, E);
                }
                SEAM();
            }
        }
        if (do_moe) {
            const int pm = ph + (odd ? 4 : 3);
            if (EN(7) && IN(pm + 0)) REPS(7) { const auto* ap = KARG(); unsigned char* ws = ap->ws; MKFRAME(F, ws); const bool dry = (rep_ == 0) && ((DBG_DUP >> 7) & 1);
                norm_proj_phase<false>(F, P_XB(ws), nullptr, nullptr, nullptr, MV(ws) + 4 * D, MV(ws) + 3 * D, ap->in[11] + (size_t)L * D * NEXP, NEXP, ap->in[12] + L * NEXP, P_HB(ws), nullptr, (unsigned*)(F.ctl + CW_GCNT) + L * NEXP, (int*)(ws + WS_SLOTP), (float*)(ws + WS_SLOTG), dry); SEAM(); }
            if (EN(8) && IN(pm + 1)) { REPS(8) { const auto* ap = KARG(); unsigned char* ws = ap->ws; MKFRAME(F, ws);
                moe_setup(F, (unsigned*)(F.ctl + CW_GCNT) + L * NEXP, 2 * FF / 256);
                pg8::SchedMoe<true, false> S{(const char*)P_HB(ws), (const char*)(ws + WS_W1) + (size_t)L * NEXP * 2 * FF * D, 0, (size_t)2 * FF * D, (size_t)256 * D, (const int*)(ws + WS_SLOTP), (const float*)(ws + WS_SLOTG), ap->in[14] + (size_t)L * NEXP * 2 * FF, (const LAS int*)(F.lds + UL_OFF)};
                pg8::EpiSwiglu E{(unsigned char*)(ws + WS_ACT), 1.0f / (pg8::FP8_SA * pg8::FP8_SW)};
                pg8::gemm_phase<pg8::EpiSwiglu, pg8::SchedMoe<true, false>, true, true>(F.lds + RING_OFF, F.lds + IDX_OFF, D / 128, D, D, S, E); SEAM(); } }
            if (EN(9) && IN(pm + 2)) { REPS(9) { const auto* ap = KARG(); unsigned char* ws = ap->ws; MKFRAME(F, ws);
                moe_setup(F, (unsigned*)(F.ctl + CW_GCNT) + L * NEXP, D / 256, (MK_N_LAUNCHES == 1) && EN(8) && (DBG_DUP == 0));
                pg8::SchedMoe<false, true> S{(const char*)(ws + WS_ACT), (const char*)(ws + WS_W2) + (size_t)L * NEXP * D * FF, (size_t)256 * FF, (size_t)D * FF, (size_t)256 * FF, (const int*)(ws + WS_SLOTP), (const float*)(ws + WS_SLOTG), ap->in[16] + (size_t)L * NEXP * D, (const LAS int*)(F.lds + UL_OFF)};
                pg8::EpiScatter E{P_YS(ws), 1.0f / (pg8::FP8_SA * pg8::FP8_SW)};
                pg8::gemm_phase<pg8::EpiScatter, pg8::SchedMoe<false, true>, true, true>(F.lds + RING_OFF, F.lds + IDX_OFF, FF / 128, FF, FF, S, E); SEAM(); } }
        }
    }
    if (EN(10) && IN(PH_FINAL)) REPS(10) { const auto* ap = KARG(); unsigned char* ws = ap->ws; MKFRAME(F, ws); const bool dry = (rep_ == 0) && ((DBG_DUP >> 10) & 1);
        constexpr bool fin_comb = (MK_NBRANCH > 0) && (MK_NBRANCH % 2 == 0);
        constexpr int Lc = fin_comb ? MK_NBRANCH / 2 - 1 : 0;
        if (rep_ == 1) SEAM();
        static_assert(MK_NBRANCH > 0, "the final phase reads the bf16 working stream");
        rows_phase<1, true>(F, fin_comb, P_XB(ws), dry ? (void*)(ws + WS_ACT) : (void*)ap->out, P_YS(ws), P_MODV(ws) + (size_t)Lc * BATCH * 6 * D + 5 * D, nullptr, ap->in[17]);
    }
#undef IN
#undef SEAM
}

extern "C" void kernel_launch(void* const* d_in, const int* in_sizes, int n_in, void* d_out, int out_size, void* d_ws, size_t ws_size, hipStream_t stream) {
    static int grid = 0;
    if (grid == 0) {
        if (n_in != 18 || in_sizes[0] != T * D || out_size != T * D || ws_size < WS_END) { fprintf(stderr, "kernel_launch: unexpected shapes / workspace (n_in %d, in0 %d, out %d, ws %zu, need %zu); nothing launched\n", n_in, n_in > 0 ? in_sizes[0] : -1, out_size, ws_size, (size_t)WS_END); grid = -1; return; }
        int dev = 0, cus = 0, per_cu = 0;
        if (hipGetDevice(&dev) != hipSuccess || hipDeviceGetAttribute(&cus, hipDeviceAttributeMultiprocessorCount, dev) != hipSuccess) { fprintf(stderr, "kernel_launch: device query failed\n"); grid = -1; return; }
        if (hipFuncSetAttribute((const void*)enc_fwd, hipFuncAttributeMaxDynamicSharedMemorySize, LDS_BYTES) != hipSuccess) { fprintf(stderr, "kernel_launch: hipFuncSetAttribute failed\n"); grid = -1; return; }
        if (hipOccupancyMaxActiveBlocksPerMultiprocessor(&per_cu, (const void*)enc_fwd, NWAVES * 64, LDS_BYTES) != hipSuccess || per_cu < 1)
            fprintf(stderr, "kernel_launch: note: occupancy query reports %d workgroups per CU\n", per_cu);
        (void)hipGetLastError();
        grid = cus;
        if (grid != 256) fprintf(stderr, "kernel_launch: %d CUs (built and tuned for 256)\n", grid);
    }
    if (grid < 0) return;
    if (hipMemsetAsync((char*)d_ws + WS_CTL, 0, CTL_ZERO_BYTES, stream) != hipSuccess) { fprintf(stderr, "kernel_launch: hipMemsetAsync failed\n"); return; }
    Args a{};
    for (int i = 0; i < 18; ++i) a.in[i] = (const float*)d_in[i];
    a.out = (float*)d_out; a.ws = (unsigned char*)d_ws;
#if MK_N_LAUNCHES == 1
    a.ph_lo = 0; a.ph_hi = NPH;
    hipLaunchKernelGGL(enc_fwd, dim3(grid), dim3(NWAVES * 64), LDS_BYTES, stream, a);
    { const hipError_t le = hipPeekAtLastError(); if (le != hipSuccess) fprintf(stderr, "kernel_launch: launch failed: %s\n", hipGetErrorName(le)); }
#else
    for (int ph = 0; ph < NPH; ++ph) {
        if (ph > 0 && ph < PH_FINAL) { const int L = (ph - 1) / 8, p = (ph - 1) % 8; if (p >= ((L & 1) ? 7 : 6)) continue; }
        a.ph_lo = ph; a.ph_hi = ph + 1;
        hipLaunchKernelGGL(enc_fwd, dim3(grid), dim3(NWAVES * 64), LDS_BYTES, stream, a);
        const hipError_t le = hipPeekAtLastError(); if (le != hipSuccess) { fprintf(stderr, "kernel_launch: launch %d failed: %s\n", ph, hipGetErrorName(le)); break; }
    }
#endif
}
```
